# Optimizing an MI355X kernel written in HIP

```python
import math
import jax, jax.numpy as jnp
from jax import lax
import numpy as np

D_MODEL = 1024
BATCH = 4
SEQ = 4096
DEPTH = 1
DEC_BATCH = 8
DEC_SEQ = 64
PAST_LEN = 1024

CHUNK = 64
MIX_WIDTH = D_MODEL
S5_WIDTH = MIX_WIDTH // 2
S5_GROUP = 16
S5_GROUPS = S5_WIDTH // S5_GROUP
S5_STATE = 64
GDN_WIDTH = MIX_WIDTH - S5_WIDTH
GDN_HEAD_DIM = 128
GDN_HEADS = GDN_WIDTH // GDN_HEAD_DIM
CONV_WIDTH = 4
CONV_CH = 3 * GDN_WIDTH
D_FF = -(-8 * D_MODEL // (3 * 256)) * 256
OFF_Q = S5_WIDTH
OFF_K = OFF_Q + GDN_WIDTH
OFF_V = OFF_K + GDN_WIDTH
OFF_Z = OFF_V + GDN_WIDTH
OFF_B = OFF_Z + GDN_WIDTH
OFF_A = OFF_B + GDN_HEADS
IN_COLS = OFF_A + GDN_HEADS
SPLITS = (OFF_Q, OFF_K, OFF_V, OFF_Z, OFF_B, OFF_A)
ALPHA = (2 * DEPTH) ** 0.25
BETA_INIT = (8 * DEPTH) ** -0.25
LN_EPS = 1e-5
RMS_EPS = 1e-6

kernel_name = 'hymba_s5_gdn_deepnorm_adaln_stream_step'

F32 = jnp.float32


def layer_norm(x, g=None, b=None):
    xf = x.astype(F32)
    mu = jnp.mean(xf, -1, keepdims=True)
    var = jnp.mean(jnp.square(xf - mu), -1, keepdims=True)
    y = (xf - mu) * lax.rsqrt(var + LN_EPS)
    if g is not None:
        y = y * g.astype(F32) + b.astype(F32)
    return y.astype(x.dtype)


def l2norm(t):
    return t * lax.rsqrt(jnp.sum(t * t, -1, keepdims=True) + RMS_EPS)


def causal_conv(x, buf, w):
    L = x.shape[1]
    xp = jnp.concatenate([buf.astype(x.dtype), x], axis=1)
    y = sum(xp[:, j:j + L] * w[j] for j in range(CONV_WIDTH))
    return y, xp[:, -(CONV_WIDTH - 1):]


def s5_mixer(u, h0_re, h0_im, a_re, a_im, log_dt, b_re, b_im, c_re, c_im, d_skip, w_glu):
    Bsz, L, _ = u.shape
    uf = u.astype(F32).reshape(Bsz, L, S5_GROUPS, S5_GROUP)
    a_re = a_re.astype(F32)
    a_im = a_im.astype(F32)
    dt = jnp.exp(log_dt.astype(F32))[:, None]
    mag = jnp.exp(a_re * dt)
    ab_re, ab_im = mag * jnp.cos(a_im * dt), mag * jnp.sin(a_im * dt)
    den = a_re * a_re + a_im * a_im
    num_re, num_im = ab_re - 1.0, ab_im
    f_re = (num_re * a_re + num_im * a_im) / den
    f_im = (num_im * a_re - num_re * a_im) / den
    bu_re = jnp.einsum('blgj,gpj->blgp', uf, b_re.astype(F32))
    bu_im = jnp.einsum('blgj,gpj->blgp', uf, b_im.astype(F32))
    x_re = f_re * bu_re - f_im * bu_im
    x_im = f_re * bu_im + f_im * bu_re
    h0_re = h0_re.astype(F32)
    h0_im = h0_im.astype(F32)
    x_re = x_re.at[:, 0].add(ab_re * h0_re - ab_im * h0_im)
    x_im = x_im.at[:, 0].add(ab_re * h0_im + ab_im * h0_re)
    A_re = jnp.broadcast_to(ab_re, x_re.shape)
    A_im = jnp.broadcast_to(ab_im, x_re.shape)

    def combine(e1, e2):
        a1r, a1i, b1r, b1i = e1
        a2r, a2i, b2r, b2i = e2
        return (a1r * a2r - a1i * a2i,
                a1r * a2i + a1i * a2r,
                a2r * b1r - a2i * b1i + b2r,
                a2r * b1i + a2i * b1r + b2i)

    _, _, h_re, h_im = lax.associative_scan(combine, (A_re, A_im, x_re, x_im), axis=1)
    y = (jnp.einsum('blgp,gjp->blgj', h_re, c_re.astype(F32))
         - jnp.einsum('blgp,gjp->blgj', h_im, c_im.astype(F32))
         + d_skip.astype(F32).reshape(S5_GROUPS, S5_GROUP) * uf)
    y = jax.nn.gelu(y.reshape(Bsz, L, S5_WIDTH))
    za, zb = jnp.split(y @ w_glu.astype(F32), 2, axis=-1)
    return za * jax.nn.sigmoid(zb), h_re[:, -1], h_im[:, -1]


def chunk_gated_delta(q, k, v, g, beta, s0):
    Bsz, H, L, Dh = q.shape
    C = min(CHUNK, L)
    N = L // C
    q, k, v = (t.reshape(Bsz, H, N, C, Dh) for t in (q, k, v))
    g, beta = (t.reshape(Bsz, H, N, C) for t in (g, beta))
    decay = jnp.cumsum(g, axis=-1)
    causal = jnp.tril(jnp.ones((C, C), bool))
    strict = jnp.tril(jnp.ones((C, C), bool), -1)
    diff = decay[..., :, None] - decay[..., None, :]
    dmask = jnp.exp(jnp.where(causal, diff, -jnp.inf))
    k_beta = k * beta[..., None]
    v_beta = v * beta[..., None]
    A = jnp.where(strict, jnp.einsum('bhnid,bhnjd->bhnij', k_beta, k) * dmask, 0.0)
    eye = jnp.eye(C, dtype=F32)
    T = lax.linalg.triangular_solve(eye + A, jnp.broadcast_to(eye, A.shape),
                                    left_side=True, lower=True)
    u = T @ v_beta
    w = T @ (k_beta * jnp.exp(decay)[..., None])
    qk = jnp.einsum('bhnid,bhnjd->bhnij', q, k) * dmask
    q_dec = q * jnp.exp(decay)[..., None]
    k_dec = k * jnp.exp(decay[..., -1:] - decay)[..., None]
    g_last = jnp.exp(decay[..., -1])

    def step(S, inp):
        u_n, w_n, qk_n, qd_n, kd_n, gl_n = inp
        v_new = u_n - w_n @ S
        o_n = qd_n @ S + qk_n @ v_new
        S = S * gl_n[..., None, None] + jnp.einsum('bhck,bhcv->bhkv', kd_n, v_new)
        return S, o_n

    xs = tuple(jnp.moveaxis(t, 2, 0) for t in (u, w, qk, q_dec, k_dec, g_last))
    S, o = lax.scan(step, s0, xs)
    return jnp.moveaxis(o, 0, 2).reshape(Bsz, H, L, Dh), S


def gdn_mixer(q, k, v, z, b_raw, a_raw, s0, conv_buf, conv_w, a_log, dt_bias, norm_g):
    Bsz, L, _ = q.shape
    qkv, new_buf = causal_conv(jnp.concatenate([q, k, v], -1), conv_buf, conv_w)
    qkv = jax.nn.silu(qkv).astype(F32)
    heads = lambda t: t.reshape(Bsz, L, GDN_HEADS, GDN_HEAD_DIM).transpose(0, 2, 1, 3)
    qh, kh, vh = (heads(t) for t in jnp.split(qkv, 3, axis=-1))
    qh = l2norm(qh) * GDN_HEAD_DIM ** -0.5
    kh = l2norm(kh)
    beta = jax.nn.sigmoid(b_raw.astype(F32)).transpose(0, 2, 1)
    g = -jnp.exp(a_log.astype(F32)) * jax.nn.softplus(a_raw.astype(F32) + dt_bias.astype(F32))
    o, s_new = chunk_gated_delta(qh, kh, vh, g.transpose(0, 2, 1), beta, s0.astype(F32))
    o = o.transpose(0, 2, 1, 3)
    o = o * lax.rsqrt(jnp.mean(o * o, -1, keepdims=True) + RMS_EPS) * norm_g.astype(F32)
    o = o * jax.nn.silu(z.astype(F32)).reshape(Bsz, L, GDN_HEADS, GDN_HEAD_DIM)
    return o.reshape(Bsz, L, GDN_WIDTH), s_new, new_buf


def trunk_layer(x, c, h_re, h_im, s_gdn, conv_buf,
                w_ada, b_ada, w_in, s5_a_re, s5_a_im, s5_log_dt, s5_b_re, s5_b_im,
                s5_c_re, s5_c_im, s5_d, w_s5_glu, gdn_conv_w, gdn_a_log, gdn_dt_bias,
                gdn_norm_g, w_out, ln1_g, ln1_b, w_ffn_up, w_ffn_down, ln2_g, ln2_b):
    mod = (jax.nn.silu(c) @ w_ada + b_ada)[:, None, :]
    sh1, sc1, g1, sh2, sc2, g2 = jnp.split(mod, 6, axis=-1)
    h = layer_norm(x) * (1 + sc1) + sh1
    u, q, k, v, z, b_raw, a_raw = jnp.split(h @ w_in, SPLITS, axis=-1)
    y_a, h_re, h_im = s5_mixer(u, h_re, h_im, s5_a_re, s5_a_im, s5_log_dt, s5_b_re, s5_b_im,
                               s5_c_re, s5_c_im, s5_d, w_s5_glu)
    y_b, s_gdn, conv_buf = gdn_mixer(q, k, v, z, b_raw, a_raw, s_gdn, conv_buf, gdn_conv_w,
                                     gdn_a_log, gdn_dt_bias, gdn_norm_g)
    mix = jnp.concatenate([y_a.astype(x.dtype), y_b.astype(x.dtype)], -1) @ w_out
    x = layer_norm(ALPHA * x + (1 + g1) * mix, ln1_g, ln1_b)
    h = layer_norm(x) * (1 + sc2) + sh2
    gate, up = jnp.split(h @ w_ffn_up, 2, axis=-1)
    ffn = (jax.nn.silu(gate) * up) @ w_ffn_down
    x = layer_norm(ALPHA * x + (1 + g2) * ffn, ln2_g, ln2_b)
    return x, h_re, h_im, s_gdn, conv_buf


def setup_inputs(seed: int = 0) -> dict:
    key = jax.random.key(seed)
    ks = jax.random.split(key, 32)
    nrm = lambda k, shape, s: s * jax.random.normal(k, shape, F32)
    G, P, J, H, Dh = S5_GROUPS, S5_STATE, S5_GROUP, GDN_HEADS, GDN_HEAD_DIM
    n_idx = jnp.arange(P, dtype=F32)
    dt0 = jnp.exp(jax.random.uniform(ks[22], (DEPTH, H), F32, math.log(1e-3), math.log(1e-1)))
    return {
        'x_prompt': nrm(ks[0], (BATCH, SEQ, D_MODEL), 1.0),
        'x_sample': nrm(ks[1], (DEC_BATCH, DEC_SEQ, D_MODEL), 1.0),
        'state_s5_re': nrm(ks[2], (DEPTH, DEC_BATCH, G, P), 0.3),
        'state_s5_im': nrm(ks[3], (DEPTH, DEC_BATCH, G, P), 0.3),
        'state_gdn': nrm(ks[4], (DEPTH, DEC_BATCH, H, Dh, Dh), 0.3),
        'cache_gdn_conv': nrm(ks[5], (DEPTH, DEC_BATCH, CONV_WIDTH - 1, CONV_CH), 1.0),
        'c_prompt': nrm(ks[6], (BATCH, D_MODEL), 1.0),
        'c_sample': nrm(ks[7], (DEC_BATCH, D_MODEL), 1.0),
        'w_ada': nrm(ks[8], (DEPTH, D_MODEL, 6 * D_MODEL), 0.1 * D_MODEL ** -0.5),
        'b_ada': nrm(ks[9], (DEPTH, 6 * D_MODEL), 0.01),
        'w_in': nrm(ks[10], (DEPTH, D_MODEL, IN_COLS), D_MODEL ** -0.5),
        's5_a_re': -0.5 + nrm(ks[11], (DEPTH, G, P), 0.01),
        's5_a_im': jnp.pi * n_idx + nrm(ks[12], (DEPTH, G, P), 0.01),
        's5_log_dt': jax.random.uniform(ks[13], (DEPTH, G), F32, math.log(1e-3), math.log(1e-1)),
        's5_b_re': nrm(ks[14], (DEPTH, G, P, J), (2 * J) ** -0.5),
        's5_b_im': nrm(ks[15], (DEPTH, G, P, J), (2 * J) ** -0.5),
        's5_c_re': nrm(ks[16], (DEPTH, G, J, P), P ** -0.5),
        's5_c_im': nrm(ks[17], (DEPTH, G, J, P), P ** -0.5),
        's5_d': nrm(ks[18], (DEPTH, S5_WIDTH), 1.0),
        'w_s5_glu': nrm(ks[19], (DEPTH, S5_WIDTH, 2 * S5_WIDTH), S5_WIDTH ** -0.5),
        'gdn_conv_w': nrm(ks[20], (DEPTH, CONV_WIDTH, CONV_CH), CONV_WIDTH ** -0.5),
        'gdn_a_log': jnp.log(jax.random.uniform(ks[21], (DEPTH, H), F32, 1.0, 16.0)),
        'gdn_dt_bias': dt0 + jnp.log(-jnp.expm1(-dt0)),
        'gdn_norm_g': 1.0 + nrm(ks[23], (DEPTH, Dh), 0.1),
        'w_out': nrm(ks[24], (DEPTH, MIX_WIDTH, D_MODEL), BETA_INIT * MIX_WIDTH ** -0.5),
        'ln1_g': 1.0 + nrm(ks[25], (DEPTH, D_MODEL), 0.1),
        'ln1_b': nrm(ks[26], (DEPTH, D_MODEL), 0.01),
        'w_ffn_up': nrm(ks[27], (DEPTH, D_MODEL, 2 * D_FF), D_MODEL ** -0.5),
        'w_ffn_down': nrm(ks[28], (DEPTH, D_FF, D_MODEL), BETA_INIT * D_FF ** -0.5),
        'ln2_g': 1.0 + nrm(ks[29], (DEPTH, D_MODEL), 0.1),
        'ln2_b': nrm(ks[30], (DEPTH, D_MODEL), 0.01),
    }


def reference(x_prompt, x_sample, state_s5_re, state_s5_im, state_gdn, cache_gdn_conv,
              c_prompt, c_sample, w_ada, b_ada, w_in, s5_a_re, s5_a_im, s5_log_dt,
              s5_b_re, s5_b_im, s5_c_re, s5_c_im, s5_d, w_s5_glu, gdn_conv_w, gdn_a_log,
              gdn_dt_bias, gdn_norm_g, w_out, ln1_g, ln1_b, w_ffn_up, w_ffn_down, ln2_g, ln2_b):
    bp = x_prompt.shape[0]
    xp, xs = x_prompt, x_sample
    p_re, p_im, p_gdn, p_conv = [], [], [], []
    s_re, s_im, s_gdn, s_conv = [], [], [], []
    for l in range(DEPTH):
        lw = (w_ada[l], b_ada[l], w_in[l], s5_a_re[l], s5_a_im[l], s5_log_dt[l], s5_b_re[l],
              s5_b_im[l], s5_c_re[l], s5_c_im[l], s5_d[l], w_s5_glu[l], gdn_conv_w[l],
              gdn_a_log[l], gdn_dt_bias[l], gdn_norm_g[l], w_out[l], ln1_g[l], ln1_b[l],
              w_ffn_up[l], w_ffn_down[l], ln2_g[l], ln2_b[l])
        xp, hr, hi, sg, cb = trunk_layer(
            xp, c_prompt,
            jnp.zeros((bp, S5_GROUPS, S5_STATE), F32),
            jnp.zeros((bp, S5_GROUPS, S5_STATE), F32),
            jnp.zeros((bp, GDN_HEADS, GDN_HEAD_DIM, GDN_HEAD_DIM), F32),
            jnp.zeros((bp, CONV_WIDTH - 1, CONV_CH), x_prompt.dtype),
            *lw)
        p_re.append(hr); p_im.append(hi); p_gdn.append(sg); p_conv.append(cb)
        xs, hr, hi, sg, cb = trunk_layer(
            xs, c_sample, state_s5_re[l], state_s5_im[l], state_gdn[l], cache_gdn_conv[l], *lw)
        s_re.append(hr); s_im.append(hi); s_gdn.append(sg); s_conv.append(cb)
    return (xp, xs,
            jnp.stack(p_re), jnp.stack(p_im), jnp.stack(p_gdn), jnp.stack(p_conv),
            jnp.stack(s_re), jnp.stack(s_im), jnp.stack(s_gdn), jnp.stack(s_conv))
```

```cpp
#include <hip/hip_runtime.h>
#include <cstdio>
#include <cstdint>
#include <cmath>
namespace pg8 {
#define PG8_LAS __attribute__((address_space(3)))
typedef unsigned short bf16_t;
typedef short bf16x8 __attribute__((ext_vector_type(8)));
typedef float f32x4 __attribute__((ext_vector_type(4)));
typedef unsigned u32x4 __attribute__((ext_vector_type(4)));
constexpr int BM = 256, BK = 64, HALF = 128, HTB = HALF * BK * 2  , STAGE_BYTES = 8 * HTB, NXCD = 8, WGM = 8;

__host__ __device__ __forceinline__ int lds_byte(int r, int c) { const int st = (r >> 4) * 2 + (c >> 5), rr = r & 15, cc = c & 31, ob = rr * 64 + cc * 2; return st * 1024 + (ob ^ (((ob >> 9) & 1) << 5)); }
__host__ __device__ __forceinline__ void stage_rc(int b, int& R, int& C) { const int st = b / 1024, sb = b % 1024, swz = sb ^ (((sb >> 9) & 1) << 5); R = (st >> 1) * 16 + swz / 64; C = (st & 1) * 32 + (swz % 64) / 2; }
__host__ __device__ __forceinline__ int perm32(int rho) { const int n = rho >> 4, i = rho & 15; return 8 * (i >> 2) + 4 * n + (i & 3); }

struct Unit { int pm, pn; };
struct Gemm { const bf16_t* A; const bf16_t* Bt; int M, N, K; };

struct StaticOrder {
    int nM, nN, nwg, G, c;
    __host__ __device__ void init(int M, int N, int G_, int c_) { nM = M / BM; nN = N / BM; nwg = nM * nN; G = G_; c = c_; }
    __host__ __device__ bool next(int i, Unit& u) const {
        const long L = (long)i * G + c; if (L >= nwg) return false;
        int wgid = (int)L; { const int q = nwg / NXCD, r = nwg % NXCD, xcd = wgid % NXCD, off = wgid / NXCD; wgid = (xcd < r ? xcd * (q + 1) : r * (q + 1) + (xcd - r) * q) + off; }
        const int nig = WGM * nN, gid = wgid / nig, fm = gid * WGM, gsz = (nM - fm) < WGM ? (nM - fm) : WGM;
        u.pm = fm + ((wgid % nig) % gsz); u.pn = (wgid % nig) / gsz; return true;
    }
    __device__ __forceinline__ void a_ready(const Unit&) const {}
    __device__ __forceinline__ void done(const Unit&) const {}
};

typedef float f32x2 __attribute__((ext_vector_type(2)));
typedef __bf16 bf16x2n __attribute__((ext_vector_type(2)));
__device__ __forceinline__ unsigned cvt_pk_bf16(float lo, float hi) { f32x2 v = {lo, hi}; return __builtin_bit_cast(unsigned, __builtin_convertvector(v, bf16x2n)); }

struct EpiBf16Split {
    static constexpr bool PERM = true, AFTER_DRAIN = false;
    bf16_t* O; int ldc; int split_cols; size_t split_stride;
    __device__ __forceinline__ void operator()(const f32x4 (&acc)[2][2][4][2], const Unit& u, int wr, int wc, int fr, int fq) const {
        const int row0 = u.pm * BM + wr * 64 + fr; int colt = u.pn * BM; bf16_t* base = O;
        if (split_cols) { const int t = colt / split_cols; base += (size_t)t * split_stride; colt -= t * split_cols; }
        const int col0 = colt + wc * 32 + 8 * fq;
#pragma unroll
        for (int ai = 0; ai < 2; ++ai)
#pragma unroll
            for (int m = 0; m < 4; ++m) { bf16_t* rowp = base + (size_t)(row0 + ai * HALF + m * 16) * ldc + col0;
#pragma unroll
                for (int bj = 0; bj < 2; ++bj) { const f32x4 v0 = acc[ai][bj][m][0], v1 = acc[ai][bj][m][1];
                    u32x4 w; w.x = cvt_pk_bf16(v0[0], v0[1]); w.y = cvt_pk_bf16(v0[2], v0[3]); w.z = cvt_pk_bf16(v1[0], v1[1]); w.w = cvt_pk_bf16(v1[2], v1[3]);
                    *(u32x4*)(rowp + bj * HALF) = w; } }
    }
};
template <int MODE> struct EpiGate {
    static constexpr bool PERM = true, AFTER_DRAIN = false;
    bf16_t* O; int ldc;
    __device__ __forceinline__ static float gate1(float a, float b) {
        if (MODE == 0) return a * __builtin_amdgcn_rcpf(1.0f + __expf(-b));
        else return a * __builtin_amdgcn_rcpf(1.0f + __expf(-a)) * b;
    }
    __device__ __forceinline__ void operator()(const f32x4 (&acc)[2][2][4][2], const Unit& u, int wr, int wc, int fr, int fq) const {
        const int row0 = u.pm * BM + wr * 64 + fr; const int col0 = u.pn * HALF + wc * 32 + 8 * fq;
#pragma unroll
        for (int ai = 0; ai < 2; ++ai)
#pragma unroll
            for (int m = 0; m < 4; ++m) { bf16_t* rowp = O + (size_t)(row0 + ai * HALF + m * 16) * ldc + col0;
                const f32x4 a0 = acc[ai][0][m][0], a1 = acc[ai][0][m][1], b0 = acc[ai][1][m][0], b1 = acc[ai][1][m][1];
                u32x4 w; w.x = cvt_pk_bf16(gate1(a0[0], b0[0]), gate1(a0[1], b0[1])); w.y = cvt_pk_bf16(gate1(a0[2], b0[2]), gate1(a0[3], b0[3]));
                w.z = cvt_pk_bf16(gate1(a1[0], b1[0]), gate1(a1[1], b1[1])); w.w = cvt_pk_bf16(gate1(a1[2], b1[2]), gate1(a1[3], b1[3]));
                *(u32x4*)rowp = w; }
    }
};
struct EpiRes {
    static constexpr bool PERM = false, AFTER_DRAIN = false;
    const float* xp; const float* xs; const float* gate; float* out; float alpha;
    __device__ __forceinline__ void operator()(const f32x4 (&acc)[2][2][4][2], const Unit& u, int wr, int wc, int fr, int fq) const {
        const int col0 = u.pn * BM + wc * 32 + 4 * fq;
#pragma unroll
        for (int ai = 0; ai < 2; ++ai) {
            const int seq = u.pm < 64 ? (u.pm >> 4) : 4 + 4 * (u.pm - 64) + 2 * ai + wr;
            const float* gp = gate + (size_t)seq * 6144 + col0;
#pragma unroll
            for (int m = 0; m < 4; ++m) { const int row = u.pm * BM + ai * HALF + wr * 64 + m * 16 + fr;
                const float* xr = (u.pm < 64 ? xp + (size_t)row * 1024 : xs + (size_t)(row - 16384) * 1024) + col0;
                float* orow = out + (size_t)row * 1024 + col0;
#pragma unroll
                for (int bj = 0; bj < 2; ++bj)
#pragma unroll
                    for (int n = 0; n < 2; ++n) { const f32x4 g4 = *(const f32x4*)(gp + bj * HALF + n * 16), x4 = *(const f32x4*)(xr + bj * HALF + n * 16);
                        *(f32x4*)(orow + bj * HALF + n * 16) = x4 * alpha + (g4 + 1.0f) * acc[ai][bj][m][n]; } }
        }
    }
};

template <class Epi, class Sched, bool ALIGN_EPI = false, bool SP2 = false>
__device__ __forceinline__ void gemm_phase(PG8_LAS unsigned char* lds, const Gemm g, const Sched& S, const Epi& E) {
    const int tid = threadIdx.x, wid = __builtin_amdgcn_readfirstlane(tid >> 6), lane = tid & 63, wr = wid >> 2, wc = wid & 3, fr = lane & 15, fq = lane >> 4;
    const int K = g.K, nt = K / BK;
    unsigned voffA[2], voffB[2];
#pragma unroll
    for (int i = 0; i < 2; ++i) { int R, C; stage_rc(tid * 16 + i * 8192, R, C); const int Rb = Epi::PERM ? ((R & ~31) + perm32(R & 31)) : R;
        voffA[i] = (unsigned)(R * K + C) * 2u; voffB[i] = (unsigned)(Rb * K + C) * 2u; }
    const size_t kstep = (size_t)(BK * 2);
    const size_t hstep = (size_t)HALF * K * 2;
    const size_t tstep = 2 * hstep;
    const unsigned ldsw = (unsigned)wid * 1024u;
    const int aoff = lds_byte(wr * 64 + fr, fq * 8), boff = lds_byte(wc * 32 + fr, fq * 8);
#define PG8_SA(b, h) (((b) * 2 + (h)) * HTB)
#define PG8_SB(b, h) ((4 + (b) * 2 + (h)) * HTB)
#define PG8_STAGE(bufoff, gbase, voff) do { _Pragma("unroll") for (int _i = 0; _i < 2; ++_i) \
        __builtin_amdgcn_global_load_lds((const unsigned*)((const char*)(gbase) + (voff)[_i]), (PG8_LAS unsigned*)(lds + (bufoff) + ldsw + _i * 8192), 16, 0, 0); } while (0)
#define PG8_LDA(dst, b, h) do { _Pragma("unroll") for (int m = 0; m < 4; ++m) _Pragma("unroll") for (int k = 0; k < 2; ++k) dst[m][k] = *(const PG8_LAS bf16x8*)(lds + PG8_SA(b, h) + aoff + m * 2048 + k * 1024); } while (0)
#define PG8_LDB(dst, b, h) do { _Pragma("unroll") for (int n = 0; n < 2; ++n) _Pragma("unroll") for (int k = 0; k < 2; ++k) dst[n][k] = *(const PG8_LAS bf16x8*)(lds + PG8_SB(b, h) + boff + n * 2048 + k * 1024); } while (0)
#define PG8_MMA(ai, bj, At, Bt) do { __builtin_amdgcn_s_setprio(1); _Pragma("unroll") for (int m = 0; m < 4; ++m) _Pragma("unroll") for (int n = 0; n < 2; ++n) _Pragma("unroll") for (int k = 0; k < 2; ++k) \
        acc[ai][bj][m][n] = __builtin_amdgcn_mfma_f32_16x16x32_bf16(Bt[n][k], At[m][k], acc[ai][bj][m][n], 0, 0, 0); __builtin_amdgcn_s_setprio(0); } while (0)
#define PG8_WAIT_V(n) asm volatile("s_waitcnt vmcnt(" #n ")" ::: "memory")
#define PG8_WAIT_L(n) asm volatile("s_waitcnt lgkmcnt(" #n ")" ::: "memory")
#define PG8_BAR __builtin_amdgcn_s_barrier()
#define PG8_SCHED __builtin_amdgcn_sched_barrier(0)
    Unit cur, nxt; int ui = 0;
    if (!S.next(0, cur)) return;
    f32x4 acc[2][2][4][2];
#pragma unroll
    for (int a = 0; a < 2; ++a)
#pragma unroll
        for (int b = 0; b < 2; ++b)
#pragma unroll
            for (int m = 0; m < 4; ++m)
#pragma unroll
                for (int n = 0; n < 2; ++n) acc[a][b][m][n] = (f32x4){0.f, 0.f, 0.f, 0.f};
    bf16x8 At[4][2], B0[2][2], B1[2][2];
    const char* cA = (const char*)g.A + (size_t)cur.pm * tstep; const char* cB = (const char*)g.Bt + (size_t)cur.pn * tstep;
    S.a_ready(cur);
    if constexpr (SP2) {
        PG8_STAGE(PG8_SB(0, 0), cB, voffB); PG8_STAGE(PG8_SB(0, 1), cB + hstep, voffB); PG8_STAGE(PG8_SA(0, 0), cA, voffA); PG8_STAGE(PG8_SA(0, 1), cA + hstep, voffA);
        if (wr == 1) PG8_BAR;
        PG8_WAIT_V(2); PG8_BAR;
        PG8_STAGE(PG8_SB(1, 0), cB + kstep, voffB); PG8_STAGE(PG8_SA(1, 0), cA + kstep, voffA); PG8_STAGE(PG8_SB(1, 1), cB + hstep + kstep, voffB);
        PG8_WAIT_V(6); PG8_BAR;
    } else {
        PG8_STAGE(PG8_SB(0, 0), cB, voffB); PG8_STAGE(PG8_SA(0, 0), cA, voffA); PG8_STAGE(PG8_SB(0, 1), cB + hstep, voffB); PG8_STAGE(PG8_SA(0, 1), cA + hstep, voffA);
        if (wr == 1) PG8_BAR;
        PG8_WAIT_V(4); PG8_BAR;
        PG8_STAGE(PG8_SB(1, 0), cB + kstep, voffB); PG8_STAGE(PG8_SA(1, 0), cA + kstep, voffA); PG8_STAGE(PG8_SB(1, 1), cB + hstep + kstep, voffB);
        PG8_WAIT_V(6); PG8_BAR;
    }
    for (;;) {
        const bool has_next = S.next(ui + 1, nxt);
        const char* nA = has_next ? (const char*)g.A + (size_t)nxt.pm * tstep : cA; const char* nB = has_next ? (const char*)g.Bt + (size_t)nxt.pn * tstep : cB;
        for (int t = 0; t < nt; t += 2) {
            const bool last = (t == nt - 2);
            const char* a1 = cA + (size_t)(t + 1) * kstep;
            const char* a2 = last ? nA : cA + (size_t)(t + 2) * kstep; const char* b2 = last ? nB : cB + (size_t)(t + 2) * kstep;
            const char* a3 = a2 + kstep; const char* b3 = b2 + kstep;
            if (last && has_next) S.a_ready(nxt);
            if constexpr (SP2) {
            PG8_LDB(B0, 0, 0); PG8_LDB(B1, 0, 1); PG8_SCHED; PG8_LDA(At, 0, 0); PG8_STAGE(PG8_SA(1, 1), a1 + hstep, voffA);
            PG8_WAIT_V(8); PG8_WAIT_L(0); PG8_BAR; PG8_MMA(0, 0, At, B0); PG8_MMA(0, 1, At, B1); PG8_BAR; PG8_SCHED;
            PG8_LDA(At, 0, 1); PG8_STAGE(PG8_SB(0, 0), b2, voffB); PG8_STAGE(PG8_SB(0, 1), b2 + hstep, voffB); PG8_STAGE(PG8_SA(0, 0), a2, voffA);
            PG8_WAIT_V(8); PG8_WAIT_L(0); PG8_BAR; PG8_MMA(1, 0, At, B0); PG8_MMA(1, 1, At, B1); PG8_BAR; PG8_SCHED;
            PG8_LDB(B0, 1, 0); PG8_LDB(B1, 1, 1); PG8_SCHED; PG8_LDA(At, 1, 0); PG8_STAGE(PG8_SA(0, 1), a2 + hstep, voffA);
            PG8_WAIT_V(8); PG8_WAIT_L(0); PG8_BAR; PG8_MMA(0, 0, At, B0); PG8_MMA(0, 1, At, B1); PG8_BAR; PG8_SCHED;
            PG8_LDA(At, 1, 1); PG8_STAGE(PG8_SB(1, 0), b3, voffB); PG8_STAGE(PG8_SB(1, 1), b3 + hstep, voffB); PG8_STAGE(PG8_SA(1, 0), a3, voffA);
            PG8_WAIT_V(8); PG8_WAIT_L(0); PG8_BAR; PG8_MMA(1, 0, At, B0); PG8_MMA(1, 1, At, B1); PG8_BAR; PG8_SCHED;
            } else {
            PG8_LDB(B0, 0, 0); PG8_SCHED; PG8_LDA(At, 0, 0); PG8_STAGE(PG8_SA(1, 1), a1 + hstep, voffA);
            PG8_WAIT_L(8); PG8_BAR; PG8_WAIT_L(0); PG8_MMA(0, 0, At, B0); PG8_BAR; PG8_SCHED;
            PG8_LDB(B1, 0, 1); PG8_STAGE(PG8_SB(0, 0), b2, voffB);
            PG8_BAR; PG8_WAIT_L(0); PG8_MMA(0, 1, At, B1); PG8_BAR;
            PG8_LDA(At, 0, 1); PG8_STAGE(PG8_SA(0, 0), a2, voffA);
            PG8_BAR; PG8_WAIT_L(0); PG8_MMA(1, 0, At, B0); PG8_BAR; PG8_SCHED;
            PG8_STAGE(PG8_SB(0, 1), b2 + hstep, voffB);
            PG8_WAIT_V(6); PG8_BAR; PG8_MMA(1, 1, At, B1); PG8_BAR;
            PG8_LDB(B0, 1, 0); PG8_SCHED; PG8_LDA(At, 1, 0); PG8_STAGE(PG8_SA(0, 1), a2 + hstep, voffA);
            PG8_WAIT_L(8); PG8_BAR; PG8_WAIT_L(0); PG8_MMA(0, 0, At, B0); PG8_BAR; PG8_SCHED;
            PG8_LDB(B1, 1, 1); PG8_STAGE(PG8_SB(1, 0), b3, voffB);
            PG8_BAR; PG8_WAIT_L(0); PG8_MMA(0, 1, At, B1); PG8_BAR;
            PG8_LDA(At, 1, 1); PG8_STAGE(PG8_SA(1, 0), a3, voffA);
            PG8_BAR; PG8_WAIT_L(0); PG8_MMA(1, 0, At, B0); PG8_BAR; PG8_SCHED;
            PG8_STAGE(PG8_SB(1, 1), b3 + hstep, voffB);
            PG8_WAIT_V(6); PG8_BAR; PG8_MMA(1, 1, At, B1); PG8_BAR;
            }
        }
        if constexpr (ALIGN_EPI) { if (wr == 0) PG8_BAR; }
        if constexpr (!Epi::AFTER_DRAIN) { E(acc, cur, wr, wc, fr, fq); S.done(cur); }
        if (!has_next) break;
#pragma unroll
        for (int a = 0; a < 2; ++a)
#pragma unroll
            for (int b = 0; b < 2; ++b)
#pragma unroll
                for (int m = 0; m < 4; ++m)
#pragma unroll
                    for (int n = 0; n < 2; ++n) acc[a][b][m][n] = (f32x4){0.f, 0.f, 0.f, 0.f};
        cur = nxt; cA = nA; cB = nB; ++ui;
        if constexpr (ALIGN_EPI) { if (wr == 1) PG8_BAR; }
    }
    PG8_WAIT_V(0);
    if constexpr (!ALIGN_EPI) { if (wr == 0) PG8_BAR; }
    PG8_BAR;
    if constexpr (Epi::AFTER_DRAIN) { E.fused(acc, cur, wr, wc, fr, fq, lds, wid, lane); S.done(cur); }
#undef PG8_SA
#undef PG8_SB
#undef PG8_STAGE
#undef PG8_LDA
#undef PG8_LDB
#undef PG8_MMA
#undef PG8_WAIT_V
#undef PG8_WAIT_L
#undef PG8_BAR
#undef PG8_SCHED
}
}

#define DI __device__ __forceinline__
#define GAS __attribute__((address_space(1)))
#define LAS __attribute__((address_space(3)))
typedef unsigned short bf16;
typedef unsigned v4u __attribute__((ext_vector_type(4)));
typedef unsigned v2u __attribute__((ext_vector_type(2)));
typedef float f32x2 __attribute__((ext_vector_type(2)));
typedef float f32x4 __attribute__((ext_vector_type(4)));
typedef float f32x8 __attribute__((ext_vector_type(8)));
typedef float f32x16 __attribute__((ext_vector_type(16)));
typedef short bf16x8 __attribute__((ext_vector_type(8)));
typedef short bf16x4 __attribute__((ext_vector_type(4)));
typedef __bf16 bf16x8n __attribute__((ext_vector_type(8)));
typedef __bf16 bf16x4n __attribute__((ext_vector_type(4)));
typedef __bf16 bf16x2n __attribute__((ext_vector_type(2)));
typedef GAS unsigned gu32;
#define RLX_AGENT __ATOMIC_RELAXED, __HIP_MEMORY_SCOPE_AGENT
#define LDS_WAIT() asm volatile("s_waitcnt lgkmcnt(0)" ::: "memory")
#define VM_WAIT() asm volatile("s_waitcnt vmcnt(0)" ::: "memory")

constexpr int NWAVES = 8;
constexpr int T = 16896, TP = 16384, D = 1024, DFF = 2816, NIN = 2560, NCHUNK = 264, NITEM = 1056;
constexpr float LN_EPS = 1e-5f, RMS_EPS = 1e-6f, ALPHA = 1.18920711500272f;
enum { I_XP = 0, I_XS, I_S5RE, I_S5IM, I_SGDN, I_CONV, I_CP, I_CS, I_WADA, I_BADA, I_WIN, I_ARE, I_AIM, I_LOGDT, I_BRE, I_BIM, I_CRE, I_CIM, I_S5D, I_WGLU,
       I_CONVW, I_ALOG, I_DTB, I_NORMG, I_WOUT, I_LN1G, I_LN1B, I_WUP, I_WDOWN, I_LN2G, I_LN2B, N_IN };
constexpr size_t O_Y = 0, O_S5RE_P = 17301504, O_S5IM_P = O_S5RE_P + 8192, O_GDN_P = O_S5IM_P + 8192, O_CONV_P = O_GDN_P + 262144,
                 O_S5RE_S = O_CONV_P + 18432, O_S5IM_S = O_S5RE_S + 16384, O_GDN_S = O_S5IM_S + 16384, O_CONV_S = O_GDN_S + 524288, O_END = O_CONV_S + 36864;
static_assert(O_END == 18192384, "output size");
constexpr size_t MiB = 1u << 20, KiB = 1024;
constexpr size_t WS_CTL = 0, CTL_ZERO_BYTES = 1 * MiB;
constexpr int CW_BAR = 4096;
constexpr size_t WS_MOD = 256 * KiB;
constexpr size_t WS_MISC = 1 * MiB;
constexpr size_t MISC_S5AB = 0, MISC_BF = 32 * KiB, MISC_CF = 160 * KiB, MISC_WX = 288 * KiB, MISC_GL = 320 * KiB;
constexpr size_t WS_WIN = 2 * MiB, WS_WGLU = 7 * MiB, WS_WOUT = 8 * MiB, WS_WUP = 10 * MiB, WS_WDOWN = 21 * MiB;
constexpr size_t WS_BA = 27 * MiB, WS_E = 28 * MiB, WS_XN = 34 * MiB;
constexpr size_t PSZ = (size_t)T * 512 * 2;
constexpr size_t WS_PROJ = 67 * MiB, WS_PU = WS_PROJ, WS_PQ = WS_PROJ + PSZ, WS_PK = WS_PROJ + 2 * PSZ, WS_PV = WS_PROJ + 3 * PSZ, WS_PZ = WS_PROJ + 4 * PSZ;
constexpr size_t WS_OBUF = WS_PQ, WS_YA = WS_PV, WS_MIX = WS_XN, WS_X1 = WS_PROJ;
constexpr size_t WS_GDN = 150 * MiB, GDN_ITEM = 90112, WS_HID = WS_GDN;
constexpr size_t G_U = 0, G_WN = 32768, G_QD = 49152, G_QK = 65536, G_KD = 73728;
constexpr size_t WS_END = 241 * MiB;
static_assert(WS_PROJ + 5 * PSZ <= WS_GDN && WS_GDN + NITEM * GDN_ITEM <= WS_END && WS_HID + (size_t)T * DFF * 2 <= WS_END && WS_XN + (size_t)T * D * 2 <= WS_PROJ, "ws map");
static_assert(WS_X1 + (size_t)T * D * 4 <= WS_PZ, "X1 overlay");
constexpr int RING_BYTES = 131072, LDSCTL_OFF = RING_BYTES, MISC_OFF = LDSCTL_OFF + 320, LDS_BYTES = 147456;

DI float bf2f(unsigned short b) { return __uint_as_float((unsigned)b << 16); }
DI unsigned pk2(float lo, float hi) { f32x2 v = {lo, hi}; return __builtin_bit_cast(unsigned, __builtin_convertvector(v, bf16x2n)); }
DI unsigned short f2bf(float x) { return (unsigned short)(pk2(x, 0.f) & 0xffffu); }
DI bf16x8 pack8(const f32x16& x, const int s) {
    f32x8 v;
#pragma unroll
    for (int j = 0; j < 8; ++j) v[j] = x[8 * s + j];
    return __builtin_bit_cast(bf16x8, __builtin_convertvector(v, bf16x8n));
}
DI float wave_sum(float v) {
#pragma unroll
    for (int o = 1; o < 64; o <<= 1) v += __shfl_xor(v, o);
    return v;
}
DI int crow(int reg, int h) { return (reg & 3) + 8 * (reg >> 2) + 4 * h; }
#define MFMA32(a, b, c) __builtin_amdgcn_mfma_f32_32x32x16_bf16((a), (b), (c), 0, 0, 0)
#define MFMA16(a, b, c) __builtin_amdgcn_mfma_f32_16x16x32_bf16((a), (b), (c), 0, 0, 0)

struct Args { const float* in[N_IN]; float* out; unsigned char* ws; int ph_lo, ph_hi; };

DI int seq_of_row(int row) { return row < TP ? (row >> 12) : 4 + ((row - TP) >> 6); }

DI void p0_transpose_item(const float* W, int K, int N, bf16* WT, int n0s, int n0d, int k0, LAS float* scr, int lane) {
#pragma unroll 8
    for (int i = 0; i < 32; ++i) { const int kk = 2 * i + (lane >> 5); scr[kk * 33 + (lane & 31)] = W[(size_t)(k0 + kk) * N + n0s + (lane & 31)]; }
    LDS_WAIT(); asm volatile("" ::: "memory");
    const int c = lane & 7;
#pragma unroll
    for (int j = 0; j < 4; ++j) { const int n = (lane >> 3) + 8 * j; const LAS float* s = scr + (8 * c) * 33 + n;
        v4u o; o.x = pk2(s[0 * 33], s[1 * 33]); o.y = pk2(s[2 * 33], s[3 * 33]); o.z = pk2(s[4 * 33], s[5 * 33]); o.w = pk2(s[6 * 33], s[7 * 33]);
        *(GAS v4u*)(WT + (size_t)(n0d + n) * K + k0 + 8 * c) = o; }
    LDS_WAIT(); asm volatile("" ::: "memory");
}
DI void phase0(const Args& a, LAS unsigned char* L, int tid, int lane, int wave, int gw, int NGW) {
    unsigned char* ws = a.ws;
    LAS float* scT = (LAS float*)L;
    for (int i = tid; i < 12 * 1024; i += NWAVES * 64) { const int s = i >> 10, k = i & 1023; const float c = s < 4 ? a.in[I_CP][s * 1024 + k] : a.in[I_CS][(s - 4) * 1024 + k];
        scT[k * 12 + s] = c / (1.0f + expf(-c)); }
    __syncthreads();
    LAS float* scr = (LAS float*)(L + 49152 + wave * 8448);
    constexpr int N_ADA = 384, N_S5 = 32, N_WX = 8;
    constexpr int I_WINT = (D / 64) * (NIN / 32), I_GLU = (512 / 64) * (1024 / 32), I_OUT = (D / 64) * (D / 32), I_UP = (D / 64) * (2 * DFF / 32), I_DOWN = (DFF / 64) * (D / 32);
    constexpr int NITEMS = N_ADA + N_S5 + N_WX + I_WINT + I_GLU + I_OUT + I_UP + I_DOWN;
    for (int it0 = gw; it0 < NITEMS; it0 += NGW) {
        int it = it0;
        if (it < N_ADA) {
            const int cb = it >> 4, kc = it & 15;
            f32x4 acc[12];
#pragma unroll
            for (int s = 0; s < 12; ++s) acc[s] = (f32x4){0.f, 0.f, 0.f, 0.f};
            const float* wp = a.in[I_WADA] + (size_t)(kc * 64) * 6144 + cb * 256 + 4 * lane;
#pragma unroll 4
            for (int kk = 0; kk < 64; ++kk) { const f32x4 w = *(const f32x4*)(wp + (size_t)kk * 6144);
                const LAS f32x4* sp = (const LAS f32x4*)(scT + (kc * 64 + kk) * 12); const f32x4 s0 = sp[0], s1 = sp[1], s2 = sp[2];
                acc[0] += w * s0.x; acc[1] += w * s0.y; acc[2] += w * s0.z; acc[3] += w * s0.w; acc[4] += w * s1.x; acc[5] += w * s1.y; acc[6] += w * s1.z; acc[7] += w * s1.w;
                acc[8] += w * s2.x; acc[9] += w * s2.y; acc[10] += w * s2.z; acc[11] += w * s2.w; }
            if (kc == 0) { const f32x4 b = *(const f32x4*)(a.in[I_BADA] + cb * 256 + 4 * lane);
#pragma unroll
                for (int s = 0; s < 12; ++s) acc[s] += b; }
            float* mod = (float*)(ws + WS_MOD) + cb * 256 + 4 * lane;
#pragma unroll
            for (int s = 0; s < 12; ++s)
#pragma unroll
                for (int e = 0; e < 4; ++e) (void)__hip_atomic_fetch_add(mod + s * 6144 + e, acc[s][e], RLX_AGENT);
            continue;
        }
        it -= N_ADA;
        if (it < N_S5) {
            const int g = it, p = lane;
            const float are = a.in[I_ARE][g * 64 + p], aim = a.in[I_AIM][g * 64 + p], dt = expf(a.in[I_LOGDT][g]);
            const float mag = expf(are * dt), ang = aim * dt, abr = mag * cosf(ang), abi = mag * sinf(ang);
            const float mag64 = expf(64.0f * are * dt), ang64 = 64.0f * ang, a64r = mag64 * cosf(ang64), a64i = mag64 * sinf(ang64);
            const float den = are * are + aim * aim, nr = abr - 1.0f, ni = abi;
            const float fr = (nr * are + ni * aim) / den, fi = (ni * are - nr * aim) / den;
            ((f32x4*)(ws + WS_MISC + MISC_S5AB))[g * 64 + p] = (f32x4){abr, abi, a64r, a64i};
            const float* bre = a.in[I_BRE] + (size_t)(g * 64 + p) * 16; const float* bim = a.in[I_BIM] + (size_t)(g * 64 + p) * 16;
            float Br[16], Bi[16];
#pragma unroll
            for (int i = 0; i < 16; ++i) { const float br = bre[i], bi = bim[i]; Br[i] = fr * br - fi * bi; Bi[i] = fr * bi + fi * br; }
            v4u* BF = (v4u*)(ws + WS_MISC + MISC_BF);
            const int n = p & 31, tre = p >> 5, tim = 2 + (p >> 5);
#pragma unroll
            for (int kh = 0; kh < 2; ++kh) {
                v4u o; o.x = pk2(Br[8 * kh + 0], Br[8 * kh + 1]); o.y = pk2(Br[8 * kh + 2], Br[8 * kh + 3]); o.z = pk2(Br[8 * kh + 4], Br[8 * kh + 5]); o.w = pk2(Br[8 * kh + 6], Br[8 * kh + 7]);
                BF[(g * 4 + tre) * 64 + n + 32 * kh] = o;
                o.x = pk2(Bi[8 * kh + 0], Bi[8 * kh + 1]); o.y = pk2(Bi[8 * kh + 2], Bi[8 * kh + 3]); o.z = pk2(Bi[8 * kh + 4], Bi[8 * kh + 5]); o.w = pk2(Bi[8 * kh + 6], Bi[8 * kh + 7]);
                BF[(g * 4 + tim) * 64 + n + 32 * kh] = o; }
            v4u* CF = (v4u*)(ws + WS_MISC + MISC_CF);
            const int j = lane & 15, kq = lane >> 4;
            const float* cre = a.in[I_CRE] + (size_t)(g * 16 + j) * 64; const float* cim = a.in[I_CIM] + (size_t)(g * 16 + j) * 64;
#pragma unroll
            for (int s = 0; s < 4; ++s) { float v[8];
#pragma unroll
                for (int jj = 0; jj < 8; ++jj) { const int kidx = 32 * s + 8 * kq + jj, p32 = kidx >> 2, c4 = kidx & 3, pp = p32 + ((c4 & 2) ? 32 : 0); v[jj] = (c4 & 1) ? -cim[pp] : cre[pp]; }
                v4u o; o.x = pk2(v[0], v[1]); o.y = pk2(v[2], v[3]); o.z = pk2(v[4], v[5]); o.w = pk2(v[6], v[7]);
                CF[(g * 4 + s) * 64 + lane] = o; }
            continue;
        }
        it -= N_S5;
        if (it < N_WX) {
            float* WX = (float*)(ws + WS_MISC + MISC_WX);
            for (int i = 0; i < 16; ++i) { const int k = lane + 64 * i; WX[it * 1024 + k] = a.in[I_WIN][(size_t)k * 2568 + 2560 + it]; }
            continue;
        }
        it -= N_WX;
        if (it < I_WINT) { const int nblk = NIN / 32, kb = it / nblk, nb = it % nblk; p0_transpose_item(a.in[I_WIN], D, 2568, (bf16*)(ws + WS_WIN), 32 * nb, 32 * nb, 64 * kb, scr, lane); continue; }
        it -= I_WINT;
        if (it < I_GLU) { const int nblk = 1024 / 32, kb = it / nblk, nb = it % nblk, nd = 32 * nb, ns = ((nd >> 7) & 1) * 512 + (nd >> 8) * 128 + (nd & 127);
            p0_transpose_item(a.in[I_WGLU], 512, 1024, (bf16*)(ws + WS_WGLU), ns, nd, 64 * kb, scr, lane); continue; }
        it -= I_GLU;
        if (it < I_OUT) { const int nblk = D / 32, kb = it / nblk, nb = it % nblk; p0_transpose_item(a.in[I_WOUT], D, D, (bf16*)(ws + WS_WOUT), 32 * nb, 32 * nb, 64 * kb, scr, lane); continue; }
        it -= I_OUT;
        if (it < I_UP) { const int nblk = 2 * DFF / 32, kb = it / nblk, nb = it % nblk, nd = 32 * nb, ns = ((nd >> 7) & 1) * DFF + (nd >> 8) * 128 + (nd & 127);
            p0_transpose_item(a.in[I_WUP], D, 2 * DFF, (bf16*)(ws + WS_WUP), ns, nd, 64 * kb, scr, lane); continue; }
        it -= I_UP;
        { const int nblk = D / 32, kb = it / nblk, nb = it % nblk; p0_transpose_item(a.in[I_WDOWN], DFF, D, (bf16*)(ws + WS_WDOWN), 32 * nb, 32 * nb, 64 * kb, scr, lane); }
    }
}

DI void phase1(const Args& a, LAS unsigned char* L, int tid, int lane, int gw, int NGW) {
    unsigned char* ws = a.ws;
    LAS float* wx = (LAS float*)L;
    { const float* WXg = (const float*)(ws + WS_MISC + MISC_WX); for (int i = tid; i < 8192; i += NWAVES * 64) wx[i] = WXg[i]; }
    __syncthreads();
    const float* mod = (const float*)(ws + WS_MOD);
    for (int row = gw; row < T; row += NGW) {
        const float* xr = row < TP ? a.in[I_XP] + (size_t)row * D : a.in[I_XS] + (size_t)(row - TP) * D;
        const float* md = mod + seq_of_row(row) * 6144;
        f32x4 v[4]; float s = 0.f;
#pragma unroll
        for (int j = 0; j < 4; ++j) { v[j] = *(const f32x4*)(xr + 4 * lane + 256 * j); s += (v[j].x + v[j].y) + (v[j].z + v[j].w); }
        const float mean = wave_sum(s) * (1.f / D); float s2 = 0.f;
#pragma unroll
        for (int j = 0; j < 4; ++j) { v[j] = v[j] - mean; s2 += (v[j].x * v[j].x + v[j].y * v[j].y) + (v[j].z * v[j].z + v[j].w * v[j].w); }
        const float rstd = 1.f / sqrtf(wave_sum(s2) * (1.f / D) + LN_EPS);
        bf16* orow = (bf16*)(ws + WS_XN) + (size_t)row * D;
#pragma unroll
        for (int j = 0; j < 4; ++j) { const int col = 4 * lane + 256 * j; const f32x4 sh = *(const f32x4*)(md + col), sc = *(const f32x4*)(md + 1024 + col);
            v[j] = v[j] * rstd * (sc + 1.0f) + sh;
            v2u o; o.x = pk2(v[j].x, v[j].y); o.y = pk2(v[j].z, v[j].w); *(v2u*)(orow + col) = o; }
        float d[8];
#pragma unroll
        for (int c = 0; c < 8; ++c) { float acc = 0.f;
#pragma unroll
            for (int j = 0; j < 4; ++j) { const f32x4 w = *(const LAS f32x4*)(wx + c * 1024 + 4 * lane + 256 * j); acc += (v[j].x * w.x + v[j].y * w.y) + (v[j].z * w.z + v[j].w * w.w); }
            d[c] = wave_sum(acc); }
        float ov = d[0];
#pragma unroll
        for (int c = 1; c < 8; ++c) ov = lane == c ? d[c] : ov;
        if (lane < 8) ((float*)(ws + WS_BA))[(size_t)row * 8 + lane] = ov;
    }
}

constexpr int GP_KS = 0, GP_QS = 17408, GP_VS = 34816, GP_WF = 67584, GP_AS = 101376, GP_QK = 117760, GP_DEC = 126976, WF_LD = 132;
DI void gdn_prep_item(const Args& a, LAS unsigned char* L, int item, int tid, int lane, int wave) {
    unsigned char* ws = a.ws;
    asm volatile("" : "+v"(L), "+v"(tid), "+v"(lane));
    const int c = item >> 2, h = item & 3;
    const int seq = c < 256 ? (c >> 6) : 4 + (c - 256), cis = c < 256 ? (c & 63) : 0, row0 = 64 * c;
    const bool last_chunk = c < 256 ? (cis == 63) : true;
    LAS bf16* Ks = (LAS bf16*)(L + GP_KS); LAS bf16* Qs = (LAS bf16*)(L + GP_QS); LAS float* Wf = (LAS float*)(L + GP_WF);
    LAS float* Vs = (LAS float*)(L + GP_VS); LAS float* As = (LAS float*)(L + GP_AS); LAS bf16* QKs = (LAS bf16*)(L + GP_QK);
    LAS float* dec = (LAS float*)(L + GP_DEC); LAS float* betas = dec + 64; LAS float* edec = dec + 128; LAS float* edl = dec + 192;
    unsigned char* gbase = ws + WS_GDN + (size_t)item * GDN_ITEM;
    {
        const int t0 = 8 * wave, ch = h * 128 + 2 * lane;
#pragma unroll
        for (int which = 0; which < 3; ++which) {
            const bf16* src = (const bf16*)(ws + WS_PQ + (size_t)which * PSZ);
            float x[11][2];
#pragma unroll
            for (int i = 0; i < 11; ++i) { const int t = t0 - 3 + i;
                if (t >= 0 || cis > 0) { const unsigned u = *(const unsigned*)(src + (size_t)(row0 + t) * 512 + ch); x[i][0] = bf2f((unsigned short)(u & 0xffffu)); x[i][1] = bf2f((unsigned short)(u >> 16)); }
                else if (seq >= 4) { const f32x2 cv = *(const f32x2*)(a.in[I_CONV] + (size_t)((seq - 4) * 3 + (3 + t)) * 1536 + which * 512 + ch); x[i][0] = cv.x; x[i][1] = cv.y; }
                else { x[i][0] = 0.f; x[i][1] = 0.f; } }
            float cw[4][2];
#pragma unroll
            for (int j = 0; j < 4; ++j) { const f32x2 w2 = *(const f32x2*)(a.in[I_CONVW] + (size_t)j * 1536 + which * 512 + ch); cw[j][0] = w2.x; cw[j][1] = w2.y; }
#pragma unroll
            for (int tt = 0; tt < 8; ++tt) {
                float y0 = 0.f, y1 = 0.f;
#pragma unroll
                for (int j = 0; j < 4; ++j) { y0 += cw[j][0] * x[tt + j][0]; y1 += cw[j][1] * x[tt + j][1]; }
                y0 = y0 / (1.0f + __expf(-y0)); y1 = y1 / (1.0f + __expf(-y1));
                if (which < 2) { const float ss = wave_sum(y0 * y0 + y1 * y1); const float sc = (which == 0 ? 0.08838834764831845f : 1.0f) / sqrtf(ss + RMS_EPS);
                    *(LAS unsigned*)((which == 0 ? Qs : Ks) + (t0 + tt) * 136 + 2 * lane) = pk2(y0 * sc, y1 * sc); }
                else *(LAS f32x2*)(Vs + (t0 + tt) * 128 + 2 * lane) = (f32x2){y0, y1};
            }
            if (last_chunk && wave == 7) {
                float* co = a.out + (seq < 4 ? O_CONV_P + (size_t)seq * 3 * 1536 : O_CONV_S + (size_t)(seq - 4) * 3 * 1536) + which * 512 + ch;
#pragma unroll
                for (int j = 0; j < 3; ++j) *(f32x2*)(co + (size_t)j * 1536) = (f32x2){x[8 + j][0], x[8 + j][1]};
            }
        }
    }
    if (wave == 0) {
        const float* BA = (const float*)(ws + WS_BA) + (size_t)(row0 + lane) * 8;
        const float braw = BA[h], araw = BA[4 + h];
        const float beta = 1.0f / (1.0f + expf(-braw));
        const float xx = araw + a.in[I_DTB][h]; const float sp = xx > 20.f ? xx : log1pf(expf(xx));
        float g = -expf(a.in[I_ALOG][h]) * sp;
#pragma unroll
        for (int o = 1; o < 64; o <<= 1) { const float t = __shfl_up(g, o); if (lane >= o) g += t; }
        const float dl = __shfl(g, 63);
        dec[lane] = g; betas[lane] = beta; edec[lane] = expf(g); edl[lane] = expf(dl - g);
        if (lane == 0) ((float*)(ws + WS_MISC + MISC_GL))[item] = expf(dl);
    }
    __syncthreads();
    {
        const int mat = wave >> 2, ti = wave & 3, r16 = lane & 15, kq = lane >> 4;
        const LAS bf16* Asrc = mat ? Qs : Ks;
        bf16x8 afr[4];
#pragma unroll
        for (int s = 0; s < 4; ++s) afr[s] = *(const LAS bf16x8*)(Asrc + (16 * ti + r16) * 136 + 32 * s + 8 * kq);
        for (int tj = 0; tj < 4; ++tj) {
            f32x4 acc = (f32x4){0.f, 0.f, 0.f, 0.f};
            if (tj <= ti) {
#pragma unroll
                for (int s = 0; s < 4; ++s) { const bf16x8 b = *(const LAS bf16x8*)(Ks + (16 * tj + r16) * 136 + 32 * s + 8 * kq); acc = MFMA16(afr[s], b, acc); }
            }
            const int j = 16 * tj + r16; const float dj = dec[j];
#pragma unroll
            for (int reg = 0; reg < 4; ++reg) { const int i = 16 * ti + 4 * kq + reg;
                if (mat == 0) { const float v = (j < i) ? betas[i] * acc[reg] * expf(dec[i] - dj) : 0.f; As[i * 64 + j] = v; }
                else { const float v = (j <= i) ? acc[reg] * expf(dec[i] - dj) : 0.f; QKs[i * 72 + j] = f2bf(v); } }
        }
    }
    __syncthreads();
    if (wave < 4) {
        const int cc = tid & 127; const bool is_u = wave < 2;
        LAS float* Xs = is_u ? Vs : Wf; const int xld = is_u ? 128 : WF_LD;
#pragma unroll 1
        for (int b = 0; b < 4; ++b) {
            float acc[16];
            if (is_u) {
#pragma unroll
                for (int r = 0; r < 16; ++r) acc[r] = Vs[(16 * b + r) * 128 + cc] * betas[16 * b + r];
            } else {
#pragma unroll
                for (int r = 0; r < 16; ++r) acc[r] = bf2f(Ks[(16 * b + r) * 136 + cc]) * (betas[16 * b + r] * edec[16 * b + r]);
            }
#pragma unroll 1
            for (int j = 0; j < 16 * b; j += 4) {
                const float x0 = Xs[j * xld + cc], x1 = Xs[(j + 1) * xld + cc], x2 = Xs[(j + 2) * xld + cc], x3 = Xs[(j + 3) * xld + cc];
#pragma unroll
                for (int r = 0; r < 16; ++r) { const f32x4 av = *(const LAS f32x4*)(As + (16 * b + r) * 64 + j); acc[r] -= (av.x * x0 + av.y * x1) + (av.z * x2 + av.w * x3); }
            }
#pragma unroll
            for (int r = 1; r < 16; ++r) {
#pragma unroll
                for (int j4 = 0; j4 < (r + 3) / 4; ++j4) { const f32x4 av = *(const LAS f32x4*)(As + (16 * b + r) * 64 + 16 * b + 4 * j4);
#pragma unroll
                    for (int e = 0; e < 4; ++e) if (4 * j4 + e < r) acc[r] -= av[e] * acc[4 * j4 + e]; }
            }
#pragma unroll
            for (int r = 0; r < 16; ++r) Xs[(16 * b + r) * xld + cc] = acc[r];
        }
    } else {
        const int t2 = tid - 256;
#pragma unroll
        for (int q = 0; q < 4; ++q) { const int chunk = t2 + 256 * q, fl = chunk & 63, s = (chunk >> 6) & 7, mt = chunk >> 9, tok = 32 * mt + (fl & 31), hh = fl >> 5;
            const bf16x4 p0 = *(const LAS bf16x4*)(Qs + tok * 136 + 16 * s + 4 * hh), p1 = *(const LAS bf16x4*)(Qs + tok * 136 + 16 * s + 8 + 4 * hh); const float e = edec[tok];
            v4u o; o.x = pk2(bf2f(p0[0]) * e, bf2f(p0[1]) * e); o.y = pk2(bf2f(p0[2]) * e, bf2f(p0[3]) * e); o.z = pk2(bf2f(p1[0]) * e, bf2f(p1[1]) * e); o.w = pk2(bf2f(p1[2]) * e, bf2f(p1[3]) * e);
            ((v4u*)(gbase + G_QD))[chunk] = o; }
#pragma unroll
        for (int q = 0; q < 2; ++q) { const int chunk = t2 + 256 * q, fl = chunk & 63, k4 = (chunk >> 6) & 3, mt = chunk >> 8, i = 32 * mt + (fl & 31), hh = fl >> 5;
            const v2u p0 = *(const LAS v2u*)(QKs + i * 72 + 16 * k4 + 4 * hh), p1 = *(const LAS v2u*)(QKs + i * 72 + 16 * k4 + 8 + 4 * hh);
            ((v4u*)(gbase + G_QK))[chunk] = (v4u){p0.x, p0.y, p1.x, p1.y}; }
#pragma unroll
        for (int q = 0; q < 4; ++q) { const int chunk = t2 + 256 * q, fl = chunk & 63, k4 = (chunk >> 6) & 3, mtk = chunk >> 8, dk = 32 * mtk + (fl & 31), hh = fl >> 5;
            float v[8];
#pragma unroll
            for (int j = 0; j < 8; ++j) { const int tok = 16 * k4 + 8 * (j >> 2) + 4 * hh + (j & 3); v[j] = bf2f(Ks[tok * 136 + dk]) * edl[tok]; }
            v4u o; o.x = pk2(v[0], v[1]); o.y = pk2(v[2], v[3]); o.z = pk2(v[4], v[5]); o.w = pk2(v[6], v[7]);
            ((v4u*)(gbase + G_KD))[chunk] = o; }
    }
    __syncthreads();
    if (wave < 2) {
        const int dv = tid & 127, sl = dv >> 5, l32 = dv & 31;
        f32x4* U4 = (f32x4*)(gbase + G_U);
#pragma unroll
        for (int mt = 0; mt < 2; ++mt)
#pragma unroll
            for (int q = 0; q < 4; ++q)
#pragma unroll
                for (int hf = 0; hf < 2; ++hf) { const int tb = 32 * mt + 8 * q + 4 * hf;
                    U4[(((sl * 2 + mt) * 4 + q) * 2 + hf) * 32 + l32] = (f32x4){Vs[tb * 128 + dv], Vs[(tb + 1) * 128 + dv], Vs[(tb + 2) * 128 + dv], Vs[(tb + 3) * 128 + dv]}; }
    }
#pragma unroll
    for (int q = 0; q < 2; ++q) { const int chunk = tid + 512 * q, fl = chunk & 63, s = (chunk >> 6) & 7, mt = chunk >> 9, tok = 32 * mt + (fl & 31), hh = fl >> 5;
        const f32x4 p0 = *(const LAS f32x4*)(Wf + tok * WF_LD + 16 * s + 4 * hh), p1 = *(const LAS f32x4*)(Wf + tok * WF_LD + 16 * s + 8 + 4 * hh);
        ((v4u*)(gbase + G_WN))[chunk] = (v4u){pk2(-p0.x, -p0.y), pk2(-p0.z, -p0.w), pk2(-p1.x, -p1.y), pk2(-p1.z, -p1.w)}; }
    __syncthreads();
}

template <bool FINAL>
DI void s5_item(const Args& a, LAS unsigned char* Hs8, int pi, int g, int lane) {
    unsigned char* ws = a.ws;
    const int n = lane & 31, hh = lane >> 5;
    const int cx = 2 * pi, cy = 2 * pi + 1, myc = hh ? cy : cx;
    const int half_r = (n >> 2) & 1, idx_r = (n & 3) + 4 * (n >> 3);
    const int arow0 = 64 * (half_r ? cy : cx) + idx_r;
    const bf16* PU = (const bf16*)(ws + WS_PU);
    const bf16x8* BF = (const bf16x8*)(ws + WS_MISC + MISC_BF) + (size_t)(g * 4) * 64 + lane;
    bf16x8 bfr[4];
#pragma unroll
    for (int tt = 0; tt < 4; ++tt) bfr[tt] = BF[tt * 64];
    const f32x4* AB = (const f32x4*)(ws + WS_MISC + MISC_S5AB) + g * 64;
    const f32x4 ab0 = AB[n], ab1 = AB[n + 32];
    float h0r = 0.f, h0i = 0.f, h1r = 0.f, h1i = 0.f;
    const f32x2* E = (const f32x2*)(ws + WS_E);
    bf16x8 cfr[4]; float dsk = 0.f;
    LAS bf16* Hs = (LAS bf16*)Hs8;
    if (FINAL) {
        const bf16x8* CF = (const bf16x8*)(ws + WS_MISC + MISC_CF) + (size_t)(g * 4) * 64 + lane;
#pragma unroll
        for (int s = 0; s < 4; ++s) cfr[s] = CF[s * 64];
        dsk = a.in[I_S5D][16 * g + (lane & 15)];
        if (cx >= 256) {
            const int b = myc - 256;
            h0r = a.in[I_S5RE][(size_t)(b * 32 + g) * 64 + n]; h0i = a.in[I_S5IM][(size_t)(b * 32 + g) * 64 + n];
            h1r = a.in[I_S5RE][(size_t)(b * 32 + g) * 64 + n + 32]; h1i = a.in[I_S5IM][(size_t)(b * 32 + g) * 64 + n + 32];
        } else {
            const int cf = cx & ~63;
#pragma unroll 4
            for (int cp = cf; cp < cy; ++cp) {
                const f32x2 e0 = E[(size_t)(cp * 32 + g) * 64 + n], e1 = E[(size_t)(cp * 32 + g) * 64 + n + 32];
                const float n0r = ab0.z * h0r - ab0.w * h0i + e0.x, n0i = ab0.z * h0i + ab0.w * h0r + e0.y;
                const float n1r = ab1.z * h1r - ab1.w * h1i + e1.x, n1i = ab1.z * h1i + ab1.w * h1r + e1.y;
                const bool act = cp < myc;
                h0r = act ? n0r : h0r; h0i = act ? n0i : h0i; h1r = act ? n1r : h1r; h1i = act ? n1i : h1i;
            }
        }
    }
    const f32x16 zero = {0.f, 0.f, 0.f, 0.f, 0.f, 0.f, 0.f, 0.f, 0.f, 0.f, 0.f, 0.f, 0.f, 0.f, 0.f, 0.f};
    for (int sb = 0; sb < 4; ++sb) {
        const bf16x8 ua = *(const bf16x8*)(PU + (size_t)(arow0 + 16 * sb) * 512 + 16 * g + 8 * hh);
        f32x16 X0 = MFMA32(ua, bfr[0], zero), X1 = MFMA32(ua, bfr[1], zero), X2 = MFMA32(ua, bfr[2], zero), X3 = MFMA32(ua, bfr[3], zero);
#pragma unroll
        for (int idx = 0; idx < 16; ++idx) {
            const float t0r = ab0.x * h0r - ab0.y * h0i + X0[idx], t0i = ab0.x * h0i + ab0.y * h0r + X2[idx];
            const float t1r = ab1.x * h1r - ab1.y * h1i + X1[idx], t1i = ab1.x * h1i + ab1.y * h1r + X3[idx];
            h0r = t0r; h0i = t0i; h1r = t1r; h1i = t1i;
            if (FINAL) { v2u o; o.x = pk2(h0r, h0i); o.y = pk2(h1r, h1i); *(LAS v2u*)(Hs + (16 * hh + idx) * 136 + 4 * n) = o; }
        }
        if (FINAL) {
            LDS_WAIT();
            const int r16 = lane & 15, kq = lane >> 4;
#pragma unroll
            for (int mi = 0; mi < 2; ++mi) {
                f32x4 y = (f32x4){0.f, 0.f, 0.f, 0.f};
#pragma unroll
                for (int s = 0; s < 4; ++s) { const bf16x8 av = *(const LAS bf16x8*)(Hs + (16 * mi + r16) * 136 + 32 * s + 8 * kq); y = MFMA16(av, cfr[s], y); }
                const int tokb = 64 * (mi ? cy : cx) + 16 * sb + 4 * kq;
#pragma unroll
                for (int reg = 0; reg < 4; ++reg) { const size_t off = (size_t)(tokb + reg) * 512 + 16 * g + r16;
                    const float yy = y[reg] + dsk * bf2f(PU[off]);
                    const float inner = 1.5957691216057308f * (yy + 0.044715f * yy * yy * yy);
                    ((bf16*)(ws + WS_YA))[off] = f2bf(yy / (1.0f + __expf(-inner))); }
            }
            LDS_WAIT();
        }
    }
    if (!FINAL) {
        f32x2* Ew = (f32x2*)(ws + WS_E);
        Ew[(size_t)(myc * 32 + g) * 64 + n] = (f32x2){h0r, h0i}; Ew[(size_t)(myc * 32 + g) * 64 + n + 32] = (f32x2){h1r, h1i};
    } else {
        const bool lastc = myc >= 256 || (myc & 63) == 63;
        if (lastc) {
            const size_t ore = myc >= 256 ? O_S5RE_S + (size_t)((myc - 256) * 32 + g) * 64 : O_S5RE_P + (size_t)((myc >> 6) * 32 + g) * 64;
            const size_t oim = myc >= 256 ? O_S5IM_S + (size_t)((myc - 256) * 32 + g) * 64 : O_S5IM_P + (size_t)((myc >> 6) * 32 + g) * 64;
            a.out[ore + n] = h0r; a.out[ore + n + 32] = h1r; a.out[oim + n] = h0i; a.out[oim + n + 32] = h1i;
        }
    }
}

DI void gdn_chain(const Args& a, int seq, int h, int sl, int lane) {
    unsigned char* ws = a.ws;
    const int r = lane & 31, hh = lane >> 5;
    f32x16 S[4];
    if (seq >= 4) {
        const float* s0 = a.in[I_SGDN] + (size_t)((seq - 4) * 4 + h) * 16384 + 32 * sl + r;
#pragma unroll
        for (int mtk = 0; mtk < 4; ++mtk)
#pragma unroll
            for (int reg = 0; reg < 16; ++reg) S[mtk][reg] = s0[(size_t)(32 * mtk + crow(reg, hh)) * 128];
    } else {
#pragma unroll
        for (int mtk = 0; mtk < 4; ++mtk)
#pragma unroll
            for (int reg = 0; reg < 16; ++reg) S[mtk][reg] = 0.f;
    }
    const int nch = seq < 4 ? 64 : 1, c0 = seq < 4 ? seq * 64 : 256 + (seq - 4);
    const float* GL = (const float*)(ws + WS_MISC + MISC_GL);
    float* OB = (float*)(ws + WS_OBUF);
    for (int ci = 0; ci < nch; ++ci) {
        const int item = (c0 + ci) * 4 + h;
        const unsigned char* gbase = ws + WS_GDN + (size_t)item * GDN_ITEM;
        const float gl = GL[item];
        const bf16x8* Wn = (const bf16x8*)(gbase + G_WN) + lane; const bf16x8* QD = (const bf16x8*)(gbase + G_QD) + lane;
        const bf16x8* QK = (const bf16x8*)(gbase + G_QK) + lane; const bf16x8* KD = (const bf16x8*)(gbase + G_KD) + lane;
        const f32x4* U4 = (const f32x4*)(gbase + G_U);
        bf16x8 Sb[8];
#pragma unroll
        for (int s = 0; s < 8; ++s) Sb[s] = pack8(S[s >> 1], s & 1);
        f32x16 vn[2], o[2];
#pragma unroll
        for (int mt = 0; mt < 2; ++mt) {
#pragma unroll
            for (int q = 0; q < 4; ++q) { const f32x4 u = U4[(((sl * 2 + mt) * 4 + q) * 2 + hh) * 32 + r];
                vn[mt][4 * q] = u.x; vn[mt][4 * q + 1] = u.y; vn[mt][4 * q + 2] = u.z; vn[mt][4 * q + 3] = u.w; }
#pragma unroll
            for (int s = 0; s < 8; ++s) vn[mt] = MFMA32(Wn[(mt * 8 + s) * 64], Sb[s], vn[mt]);
        }
#pragma unroll
        for (int mt = 0; mt < 2; ++mt) {
#pragma unroll
            for (int reg = 0; reg < 16; ++reg) o[mt][reg] = 0.f;
#pragma unroll
            for (int s = 0; s < 8; ++s) o[mt] = MFMA32(QD[(mt * 8 + s) * 64], Sb[s], o[mt]);
        }
        bf16x8 vb[4];
#pragma unroll
        for (int k4 = 0; k4 < 4; ++k4) vb[k4] = pack8(vn[k4 >> 1], k4 & 1);
#pragma unroll
        for (int mt = 0; mt < 2; ++mt)
#pragma unroll
            for (int k4 = 0; k4 < 4; ++k4) o[mt] = MFMA32(QK[(mt * 4 + k4) * 64], vb[k4], o[mt]);
#pragma unroll
        for (int mtk = 0; mtk < 4; ++mtk) {
            S[mtk] = S[mtk] * gl;
#pragma unroll
            for (int k4 = 0; k4 < 4; ++k4) S[mtk] = MFMA32(KD[(mtk * 4 + k4) * 64], vb[k4], S[mtk]);
        }
        float* op = OB + (size_t)((c0 + ci) * 64) * 512 + h * 128 + 32 * sl + r;
#pragma unroll
        for (int mt = 0; mt < 2; ++mt)
#pragma unroll
            for (int reg = 0; reg < 16; ++reg) op[(size_t)(32 * mt + crow(reg, hh)) * 512] = o[mt][reg];
    }
    float* so = a.out + (seq < 4 ? O_GDN_P + (size_t)(seq * 4 + h) * 16384 : O_GDN_S + (size_t)((seq - 4) * 4 + h) * 16384) + 32 * sl + r;
#pragma unroll
    for (int mtk = 0; mtk < 4; ++mtk)
#pragma unroll
        for (int reg = 0; reg < 16; ++reg) so[(size_t)(32 * mtk + crow(reg, hh)) * 128] = S[mtk][reg];
}

DI void gdn_norm_rows(const Args& a, int lane, int w0, int nw) {
    unsigned char* ws = a.ws;
    const int hd = lane >> 4, dv0 = (lane & 15) * 8, col = hd * 128 + dv0;
    const f32x4 g0 = *(const f32x4*)(a.in[I_NORMG] + dv0), g1 = *(const f32x4*)(a.in[I_NORMG] + dv0 + 4);
    for (int row = w0; row < T; row += nw) {
        const float* op = (const float*)(ws + WS_OBUF) + (size_t)row * 512 + col;
        const f32x4 o0 = *(const f32x4*)op, o1 = *(const f32x4*)(op + 4);
        float ss = (o0.x * o0.x + o0.y * o0.y) + (o0.z * o0.z + o0.w * o0.w) + (o1.x * o1.x + o1.y * o1.y) + (o1.z * o1.z + o1.w * o1.w);
        ss += __shfl_xor(ss, 1); ss += __shfl_xor(ss, 2); ss += __shfl_xor(ss, 4); ss += __shfl_xor(ss, 8);
        const float rs = 1.0f / sqrtf(ss * (1.0f / 128.0f) + RMS_EPS);
        const bf16x8 z = *(const bf16x8*)((const bf16*)(ws + WS_PZ) + (size_t)row * 512 + col);
        float zz[8], y[8];
#pragma unroll
        for (int e = 0; e < 8; ++e) { const float zv = bf2f((unsigned short)z[e]); zz[e] = zv / (1.0f + __expf(-zv)); }
        y[0] = o0.x * rs * g0.x * zz[0]; y[1] = o0.y * rs * g0.y * zz[1]; y[2] = o0.z * rs * g0.z * zz[2]; y[3] = o0.w * rs * g0.w * zz[3];
        y[4] = o1.x * rs * g1.x * zz[4]; y[5] = o1.y * rs * g1.y * zz[5]; y[6] = o1.z * rs * g1.z * zz[6]; y[7] = o1.w * rs * g1.w * zz[7];
        v4u o; o.x = pk2(y[0], y[1]); o.y = pk2(y[2], y[3]); o.z = pk2(y[4], y[5]); o.w = pk2(y[6], y[7]);
        *(v4u*)((bf16*)(ws + WS_MIX) + (size_t)row * 1024 + 512 + col) = o;
    }
}

DI void phase7(const Args& a, int lane, int gw, int NGW) {
    unsigned char* ws = a.ws;
    const float* mod = (const float*)(ws + WS_MOD);
    f32x4 lg[4], lb[4];
#pragma unroll
    for (int j = 0; j < 4; ++j) { lg[j] = *(const f32x4*)(a.in[I_LN1G] + 4 * lane + 256 * j); lb[j] = *(const f32x4*)(a.in[I_LN1B] + 4 * lane + 256 * j); }
    for (int row = gw; row < T; row += NGW) {
        const float* xr = a.out + O_Y + (size_t)row * D;
        const float* md = mod + seq_of_row(row) * 6144;
        f32x4 v[4]; float s = 0.f;
#pragma unroll
        for (int j = 0; j < 4; ++j) { v[j] = *(const f32x4*)(xr + 4 * lane + 256 * j); s += (v[j].x + v[j].y) + (v[j].z + v[j].w); }
        float mean = wave_sum(s) * (1.f / D), s2 = 0.f;
#pragma unroll
        for (int j = 0; j < 4; ++j) { v[j] = v[j] - mean; s2 += (v[j].x * v[j].x + v[j].y * v[j].y) + (v[j].z * v[j].z + v[j].w * v[j].w); }
        float rstd = 1.f / sqrtf(wave_sum(s2) * (1.f / D) + LN_EPS);
        float* x1 = (float*)(ws + WS_X1) + (size_t)row * D; s = 0.f;
#pragma unroll
        for (int j = 0; j < 4; ++j) { v[j] = v[j] * rstd * lg[j] + lb[j]; *(f32x4*)(x1 + 4 * lane + 256 * j) = v[j]; s += (v[j].x + v[j].y) + (v[j].z + v[j].w); }
        mean = wave_sum(s) * (1.f / D); s2 = 0.f;
#pragma unroll
        for (int j = 0; j < 4; ++j) { v[j] = v[j] - mean; s2 += (v[j].x * v[j].x + v[j].y * v[j].y) + (v[j].z * v[j].z + v[j].w * v[j].w); }
        rstd = 1.f / sqrtf(wave_sum(s2) * (1.f / D) + LN_EPS);
        bf16* orow = (bf16*)(ws + WS_XN) + (size_t)row * D;
#pragma unroll
        for (int j = 0; j < 4; ++j) { const int col = 4 * lane + 256 * j; const f32x4 sh = *(const f32x4*)(md + 3072 + col), sc = *(const f32x4*)(md + 4096 + col);
            const f32x4 hv = v[j] * rstd * (sc + 1.0f) + sh;
            v2u o; o.x = pk2(hv.x, hv.y); o.y = pk2(hv.z, hv.w); *(v2u*)(orow + col) = o; }
    }
}
DI void phase10(const Args& a, int lane, int gw, int NGW) {
    f32x4 lg[4], lb[4];
#pragma unroll
    for (int j = 0; j < 4; ++j) { lg[j] = *(const f32x4*)(a.in[I_LN2G] + 4 * lane + 256 * j); lb[j] = *(const f32x4*)(a.in[I_LN2B] + 4 * lane + 256 * j); }
    for (int row = gw; row < T; row += NGW) {
        float* xr = a.out + O_Y + (size_t)row * D;
        f32x4 v[4]; float s = 0.f;
#pragma unroll
        for (int j = 0; j < 4; ++j) { v[j] = *(const f32x4*)(xr + 4 * lane + 256 * j); s += (v[j].x + v[j].y) + (v[j].z + v[j].w); }
        const float mean = wave_sum(s) * (1.f / D); float s2 = 0.f;
#pragma unroll
        for (int j = 0; j < 4; ++j) { v[j] = v[j] - mean; s2 += (v[j].x * v[j].x + v[j].y * v[j].y) + (v[j].z * v[j].z + v[j].w * v[j].w); }
        const float rstd = 1.f / sqrtf(wave_sum(s2) * (1.f / D) + LN_EPS);
#pragma unroll
        for (int j = 0; j < 4; ++j) *(f32x4*)(xr + 4 * lane + 256 * j) = v[j] * rstd * lg[j] + lb[j];
    }
}
#define XB_TMO      128
#define XB_XCNT(j)  (256  + 64 * (j))
#define XB_XSUB(j)  (1280 + 64 * (j))
#define XB_XGEN(j)  (2304 + 64 * (j))
#define XB_TOP      3328
#define XB_TOPGEN   3392
#define XCD_BAR_WORDS 3456
#define XB_SPIN_CAP (1u << 18)

__device__ __forceinline__ unsigned xb_ld(unsigned* p)              { return __hip_atomic_load(p, __ATOMIC_RELAXED, __HIP_MEMORY_SCOPE_AGENT); }
__device__ __forceinline__ unsigned xb_add(unsigned* p, unsigned v) { return __hip_atomic_fetch_add(p, v, __ATOMIC_RELAXED, __HIP_MEMORY_SCOPE_AGENT); }
__device__ __forceinline__ unsigned xb_xcc_id() { return (unsigned)__builtin_amdgcn_s_getreg((3 << 11) | 20) & 0xFu; }
#define XB_SPIN(cond, bar) do { unsigned _sp = 0; while (cond) { __builtin_amdgcn_s_sleep(1); \
    if ((++_sp & 255u) == 0u) { if (xb_ld(&(bar)[XB_TMO])) break; if (_sp > XB_SPIN_CAP) { atomicAdd(&(bar)[XB_TMO], 1u); break; } } } } while (0)

struct XcdBarrier {
    unsigned* bar; unsigned x;
    volatile LAS unsigned* st;
};

__device__ __forceinline__ XcdBarrier xcd_barrier_post(unsigned* bar, volatile LAS unsigned* st) {
    XcdBarrier b; b.bar = bar; b.x = xb_xcc_id(); b.st = st;
    if (threadIdx.x == 0) (void)xb_add(&bar[XB_XCNT(b.x)], 1u);
    return b;
}
__device__ __forceinline__ void xcd_barrier_complete(unsigned* bar, unsigned x, unsigned& nloc, unsigned& nx) {
    const unsigned G = gridDim.x * gridDim.y * gridDim.z;
    unsigned sum, cnt, mine, sp = 0u;
    for (;;) {
        sum = 0u; cnt = 0u; mine = 0u;
#pragma unroll
        for (unsigned j = 0; j < 16; ++j) { const unsigned c = xb_ld(&bar[XB_XCNT(j)]); sum += c; cnt += (c > 0u) ? 1u : 0u; mine = (j == x) ? c : mine; }
        if (sum == G) break;
        __builtin_amdgcn_s_sleep(1);
        if ((++sp & 255u) == 0u) { if (xb_ld(&bar[XB_TMO])) break; if (sp > XB_SPIN_CAP) { atomicAdd(&bar[XB_TMO], 1u); break; } }
    }
    nloc = mine > 0u ? mine : 1u; nx = cnt > 0u ? cnt : 1u;
}

__device__ __forceinline__ void xcd_barrier(const XcdBarrier& b) {
    asm volatile("s_waitcnt vmcnt(0)" ::: "memory");
    __syncthreads();
    if (threadIdx.x == 0) {
        unsigned* bar = b.bar;
        __builtin_amdgcn_s_waitcnt(0);
        unsigned nloc = b.st[0], nx = b.st[1];
        if (nloc == 0u) { xcd_barrier_complete(bar, b.x, nloc, nx); b.st[0] = nloc; b.st[1] = nx; }
        const unsigned old = xb_add(&bar[XB_XSUB(b.x)], 1u);
        const unsigned gen = old / nloc;
        if (old + 1u == (gen + 1u) * nloc) {
            __builtin_amdgcn_fence(__ATOMIC_RELEASE, "agent");
            asm volatile("s_waitcnt vmcnt(0)" ::: "memory");
            const unsigned og = xb_add(&bar[XB_TOP], 1u);
            const unsigned tg = og / nx;
            if (og + 1u == (tg + 1u) * nx) xb_add(&bar[XB_TOPGEN], 1u);
            else XB_SPIN(xb_ld(&bar[XB_TOPGEN]) == tg, bar);
            __builtin_amdgcn_fence(__ATOMIC_ACQUIRE, "agent");
            xb_add(&bar[XB_XGEN(b.x)], 1u);
            asm volatile("s_waitcnt vmcnt(0)" ::: "memory");
        } else {
            XB_SPIN(xb_ld(&bar[XB_XGEN(b.x)]) == gen, bar);
            __builtin_amdgcn_fence(__ATOMIC_ACQUIRE, "agent");
            asm volatile("s_waitcnt vmcnt(0)" ::: "memory");
        }
    }
    __syncthreads();
}

#ifndef MK_N_LAUNCHES
#define MK_N_LAUNCHES 1
#endif
constexpr int N_PHASES = 11;
constexpr int N_CHAIN = 48;

__global__ void __launch_bounds__(NWAVES * 64, 2) fwd_kernel(Args args) {
    extern __shared__ __attribute__((aligned(16))) unsigned char lds[];
    LAS unsigned char* L = (LAS unsigned char*)lds;
    const int tid = threadIdx.x, lane = tid & 63, wave = __builtin_amdgcn_readfirstlane(tid >> 6);
    const int G = gridDim.x, bx = blockIdx.x;
    const int vcu = (G % 8 == 0) ? (bx % 8) * (G / 8) + bx / 8 : bx;
    const int gw = vcu * NWAVES + wave, NGW = G * NWAVES;
    unsigned char* ws = args.ws;
    for (int u = tid; u < (LDS_BYTES - LDSCTL_OFF) / 4; u += NWAVES * 64) ((LAS unsigned*)(L + LDSCTL_OFF))[u] = 0u;
    __syncthreads();
    XcdBarrier bar = xcd_barrier_post((unsigned*)(ws + WS_CTL) + CW_BAR, (volatile LAS unsigned*)(L + MISC_OFF) + 8);
    const int lo = args.ph_lo, hi = args.ph_hi;
#ifndef PHASE_MASK
#define PHASE_MASK 0x7ff
#endif
#define IN(k) (((PHASE_MASK >> (k)) & 1) && lo <= (k) && (k) < hi)
#define SEAM(k) do { if (IN(k) && IN((k) + 1)) xcd_barrier(bar); } while (0)

    if (IN(0)) { phase0(args, L, tid, lane, wave, gw, NGW); SEAM(0); }
    if (IN(1)) { phase1(args, L, tid, lane, gw, NGW); SEAM(1); }
    if (IN(2)) {
        pg8::Gemm g{(const bf16*)(ws + WS_XN), (const bf16*)(ws + WS_WIN), T, NIN, D}; pg8::StaticOrder S; S.init(T, NIN, G, bx);
        pg8::EpiBf16Split E{(bf16*)(ws + WS_PU), 512, 512, (size_t)T * 512};
        pg8::gemm_phase<pg8::EpiBf16Split, pg8::StaticOrder, true, true>(L, g, S, E);
        SEAM(2);
    }
    if (IN(3)) {
#ifndef NO_GDNPREP
        for (int item = bx; item < NITEM; item += G) gdn_prep_item(args, L, item, tid, lane, wave);
#endif
#ifndef NO_S5P1
        for (int it = gw; it < (NCHUNK / 2) * 32; it += NGW) s5_item<false>(args, L, it >> 5, it & 31, lane);
#endif
        SEAM(3);
    }
    if (IN(4)) {
        const int nchw = G < N_CHAIN ? G : N_CHAIN;
        if (bx < nchw && wave < 4) {
            for (int k = bx; k < N_CHAIN; k += G) { const int seq = k < 16 ? (k >> 2) : 4 + ((k - 16) >> 2), h = k & 3; gdn_chain(args, seq, h, wave, lane); }
        } else {
            const int wid = bx >= nchw ? (bx - nchw) * NWAVES + wave : (G - nchw) * NWAVES + bx * 4 + (wave - 4);
            const int NW = (G - nchw) * NWAVES + nchw * 4;
            for (int it = wid; it < (NCHUNK / 2) * 32; it += NW) s5_item<true>(args, L + wave * 8704, it >> 5, it & 31, lane);
        }
        SEAM(4);
    }
    if (IN(5)) {
        pg8::Gemm g{(const bf16*)(ws + WS_YA), (const bf16*)(ws + WS_WGLU), T, 1024, 512}; pg8::StaticOrder S; S.init(T, 1024, G, bx);
        pg8::EpiGate<0> E{(bf16*)(ws + WS_MIX), 1024};
        pg8::gemm_phase<pg8::EpiGate<0>, pg8::StaticOrder, true, true>(L, g, S, E);
        gdn_norm_rows(args, lane, gw, NGW);
        SEAM(5);
    }
    if (IN(6)) {
        pg8::Gemm g{(const bf16*)(ws + WS_MIX), (const bf16*)(ws + WS_WOUT), T, D, D}; pg8::StaticOrder S; S.init(T, D, G, bx);
        pg8::EpiRes E{args.in[I_XP], args.in[I_XS], (const float*)(ws + WS_MOD) + 2048, args.out + O_Y, ALPHA};
        pg8::gemm_phase<pg8::EpiRes, pg8::StaticOrder, true, true>(L, g, S, E);
        SEAM(6);
    }
    if (IN(7)) { phase7(args, lane, gw, NGW); SEAM(7); }
    if (IN(8)) {
        pg8::Gemm g{(const bf16*)(ws + WS_XN), (const bf16*)(ws + WS_WUP), T, 2 * DFF, D}; pg8::StaticOrder S; S.init(T, 2 * DFF, G, bx);
        pg8::EpiGate<1> E{(bf16*)(ws + WS_HID), DFF};
        pg8::gemm_phase<pg8::EpiGate<1>, pg8::StaticOrder, true, true>(L, g, S, E);
        SEAM(8);
    }
    if (IN(9)) {
        pg8::Gemm g{(const bf16*)(ws + WS_HID), (const bf16*)(ws + WS_WDOWN), T, D, DFF}; pg8::StaticOrder S; S.init(T, D, G, bx);
        pg8::EpiRes E{(const float*)(ws + WS_X1), (const float*)(ws + WS_X1) + (size_t)TP * D, (const float*)(ws + WS_MOD) + 5120, args.out + O_Y, ALPHA};
        pg8::gemm_phase<pg8::EpiRes, pg8::StaticOrder, true, true>(L, g, S, E);
        SEAM(9);
    }
    if (IN(10)) { phase10(args, lane, gw, NGW); }
#undef IN
#undef SEAM
}

extern "C" void kernel_launch(void* const* d_in, const int* in_sizes, int n_in, void* d_out, int out_size, void* d_ws, size_t ws_size, hipStream_t stream) {
    static int grid = 0;
    if (grid == 0) {
        if (n_in != N_IN || out_size != (int)O_END || ws_size < WS_END) { fprintf(stderr, "kernel_launch: unexpected shapes (n_in %d, out %d, ws %zu); nothing launched\n", n_in, out_size, ws_size); grid = -1; return; }
        int dev = 0, cus = 0, per_cu = 0;
        if (hipGetDevice(&dev) != hipSuccess || hipDeviceGetAttribute(&cus, hipDeviceAttributeMultiprocessorCount, dev) != hipSuccess) { grid = -1; return; }
        if (hipFuncSetAttribute((const void*)fwd_kernel, hipFuncAttributeMaxDynamicSharedMemorySize, LDS_BYTES) != hipSuccess) { fprintf(stderr, "kernel_launch: hipFuncSetAttribute failed\n"); grid = -1; return; }
        if (hipOccupancyMaxActiveBlocksPerMultiprocessor(&per_cu, (const void*)fwd_kernel, NWAVES * 64, LDS_BYTES) != hipSuccess || per_cu < 1) { fprintf(stderr, "kernel_launch: occupancy query says %d blocks per CU\n", per_cu); per_cu = 1; }
        (void)hipGetLastError();
        grid = cus;
    }
    if (grid < 0) return;
    (void)hipMemsetAsync((char*)d_ws + WS_CTL, 0, CTL_ZERO_BYTES, stream);
    Args a{};
    for (int i = 0; i < N_IN; ++i) a.in[i] = (const float*)d_in[i];
    a.out = (float*)d_out; a.ws = (unsigned char*)d_ws;
#if MK_N_LAUNCHES == 1
    a.ph_lo = 0; a.ph_hi = N_PHASES;
    hipLaunchKernelGGL(fwd_kernel, dim3(grid), dim3(NWAVES * 64), LDS_BYTES, stream, a);
#else
    for (int p = 0; p < N_PHASES; ++p) { a.ph_lo = p; a.ph_hi = p + 1; hipLaunchKernelGGL(fwd_kernel, dim3(grid), dim3(NWAVES * 64), LDS_BYTES, stream, a); }
#endif
}
```

```cpp
#include <hip/hip_runtime.h>
#include <cstdio>
#include <cstdint>
#include <cmath>
namespace pg8 {
#define PG8_LAS __attribute__((address_space(3)))
typedef unsigned short bf16_t;
typedef short bf16x8 __attribute__((ext_vector_type(8)));
typedef float f32x4 __attribute__((ext_vector_type(4)));
typedef unsigned u32x4 __attribute__((ext_vector_type(4)));
constexpr int BM = 256, BK = 64, HALF = 128, HTB = HALF * BK * 2  , STAGE_BYTES = 8 * HTB, NXCD = 8, WGM = 8;

__host__ __device__ __forceinline__ int lds_byte(int r, int c) { const int st = (r >> 4) * 2 + (c >> 5), rr = r & 15, cc = c & 31, ob = rr * 64 + cc * 2; return st * 1024 + (ob ^ (((ob >> 9) & 1) << 5)); }
__host__ __device__ __forceinline__ void stage_rc(int b, int& R, int& C) { const int st = b / 1024, sb = b % 1024, swz = sb ^ (((sb >> 9) & 1) << 5); R = (st >> 1) * 16 + swz / 64; C = (st & 1) * 32 + (swz % 64) / 2; }
__host__ __device__ __forceinline__ int perm32(int rho) { const int n = rho >> 4, i = rho & 15; return 8 * (i >> 2) + 4 * n + (i & 3); }

struct Unit { int pm, pn; };
struct Gemm { const bf16_t* A; const bf16_t* Bt; int M, N, K; };

struct StaticOrder {
    int nM, nN, nwg, G, c;
    __host__ __device__ void init(int M, int N, int G_, int c_) { nM = M / BM; nN = N / BM; nwg = nM * nN; G = G_; c = c_; }
    __host__ __device__ bool next(int i, Unit& u) const {
        const long L = (long)i * G + c; if (L >= nwg) return false;
        int wgid = (int)L; { const int q = nwg / NXCD, r = nwg % NXCD, xcd = wgid % NXCD, off = wgid / NXCD; wgid = (xcd < r ? xcd * (q + 1) : r * (q + 1) + (xcd - r) * q) + off; }
        const int nig = WGM * nN, gid = wgid / nig, fm = gid * WGM, gsz = (nM - fm) < WGM ? (nM - fm) : WGM;
        u.pm = fm + ((wgid % nig) % gsz); u.pn = (wgid % nig) / gsz; return true;
    }
    __device__ __forceinline__ void a_ready(const Unit&) const {}
    __device__ __forceinline__ void done(const Unit&) const {}
};

typedef float f32x2 __attribute__((ext_vector_type(2)));
typedef __bf16 bf16x2n __attribute__((ext_vector_type(2)));
__device__ __forceinline__ unsigned cvt_pk_bf16(float lo, float hi) { f32x2 v = {lo, hi}; return __builtin_bit_cast(unsigned, __builtin_convertvector(v, bf16x2n)); }

struct EpiBf16Split {
    static constexpr bool PERM = true, AFTER_DRAIN = false;
    bf16_t* O; int ldc; int split_cols; size_t split_stride;
    __device__ __forceinline__ void operator()(const f32x4 (&acc)[2][2][4][2], const Unit& u, int wr, int wc, int fr, int fq) const {
        const int row0 = u.pm * BM + wr * 64 + fr; int colt = u.pn * BM; bf16_t* base = O;
        if (split_cols) { const int t = colt / split_cols; base += (size_t)t * split_stride; colt -= t * split_cols; }
        const int col0 = colt + wc * 32 + 8 * fq;
#pragma unroll
        for (int ai = 0; ai < 2; ++ai)
#pragma unroll
            for (int m = 0; m < 4; ++m) { bf16_t* rowp = base + (size_t)(row0 + ai * HALF + m * 16) * ldc + col0;
#pragma unroll
                for (int bj = 0; bj < 2; ++bj) { const f32x4 v0 = acc[ai][bj][m][0], v1 = acc[ai][bj][m][1];
                    u32x4 w; w.x = cvt_pk_bf16(v0[0], v0[1]); w.y = cvt_pk_bf16(v0[2], v0[3]); w.z = cvt_pk_bf16(v1[0], v1[1]); w.w = cvt_pk_bf16(v1[2], v1[3]);
                    *(u32x4*)(rowp + bj * HALF) = w; } }
    }
};
template <int MODE> struct EpiGate {
    static constexpr bool PERM = true, AFTER_DRAIN = false;
    bf16_t* O; int ldc;
    __device__ __forceinline__ static float gate1(float a, float b) {
        if (MODE == 0) return a * __builtin_amdgcn_rcpf(1.0f + __expf(-b));
        else return a * __builtin_amdgcn_rcpf(1.0f + __expf(-a)) * b;
    }
    __device__ __forceinline__ void operator()(const f32x4 (&acc)[2][2][4][2], const Unit& u, int wr, int wc, int fr, int fq) const {
        const int row0 = u.pm * BM + wr * 64 + fr; const int col0 = u.pn * HALF + wc * 32 + 8 * fq;
#pragma unroll
        for (int ai = 0; ai < 2; ++ai)
#pragma unroll
            for (int m = 0; m < 4; ++m) { bf16_t* rowp = O + (size_t)(row0 + ai * HALF + m * 16) * ldc + col0;
                const f32x4 a0 = acc[ai][0][m][0], a1 = acc[ai][0][m][1], b0 = acc[ai][1][m][0], b1 = acc[ai][1][m][1];
                u32x4 w; w.x = cvt_pk_bf16(gate1(a0[0], b0[0]), gate1(a0[1], b0[1])); w.y = cvt_pk_bf16(gate1(a0[2], b0[2]), gate1(a0[3], b0[3]));
                w.z = cvt_pk_bf16(gate1(a1[0], b1[0]), gate1(a1[1], b1[1])); w.w = cvt_pk_bf16(gate1(a1[2], b1[2]), gate1(a1[3], b1[3]));
                *(u32x4*)rowp = w; }
    }
};
struct EpiRes {
    static constexpr bool PERM = false, AFTER_DRAIN = false;
    const float* xp; const float* xs; const float* gate; float* out; float alpha;
    __device__ __forceinline__ void operator()(const f32x4 (&acc)[2][2][4][2], const Unit& u, int wr, int wc, int fr, int fq) const {
        const int col0 = u.pn * BM + wc * 32 + 4 * fq;
#pragma unroll
        for (int ai = 0; ai < 2; ++ai) {
            const int seq = u.pm < 64 ? (u.pm >> 4) : 4 + 4 * (u.pm - 64) + 2 * ai + wr;
            const float* gp = gate + (size_t)seq * 6144 + col0;
#pragma unroll
            for (int m = 0; m < 4; ++m) { const int row = u.pm * BM + ai * HALF + wr * 64 + m * 16 + fr;
                const float* xr = (u.pm < 64 ? xp + (size_t)row * 1024 : xs + (size_t)(row - 16384) * 1024) + col0;
                float* orow = out + (size_t)row * 1024 + col0;
#pragma unroll
                for (int bj = 0; bj < 2; ++bj)
#pragma unroll
                    for (int n = 0; n < 2; ++n) { const f32x4 g4 = *(const f32x4*)(gp + bj * HALF + n * 16), x4 = *(const f32x4*)(xr + bj * HALF + n * 16);
                        *(f32x4*)(orow + bj * HALF + n * 16) = x4 * alpha + (g4 + 1.0f) * acc[ai][bj][m][n]; } }
        }
    }
};

template <class Epi, class Sched, bool ALIGN_EPI = false, bool SP2 = false>
__device__ __forceinline__ void gemm_phase(PG8_LAS unsigned char* lds, const Gemm g, const Sched& S, const Epi& E) {
    const int tid = threadIdx.x, wid = __builtin_amdgcn_readfirstlane(tid >> 6), lane = tid & 63, wr = wid >> 2, wc = wid & 3, fr = lane & 15, fq = lane >> 4;
    const int K = g.K, nt = K / BK;
    unsigned voffA[2], voffB[2];
#pragma unroll
    for (int i = 0; i < 2; ++i) { int R, C; stage_rc(tid * 16 + i * 8192, R, C); const int Rb = Epi::PERM ? ((R & ~31) + perm32(R & 31)) : R;
        voffA[i] = (unsigned)(R * K + C) * 2u; voffB[i] = (unsigned)(Rb * K + C) * 2u; }
    const size_t kstep = (size_t)(BK * 2);
    const size_t hstep = (size_t)HALF * K * 2;
    const size_t tstep = 2 * hstep;
    const unsigned ldsw = (unsigned)wid * 1024u;
    const int aoff = lds_byte(wr * 64 + fr, fq * 8), boff = lds_byte(wc * 32 + fr, fq * 8);
#define PG8_SA(b, h) (((b) * 2 + (h)) * HTB)
#define PG8_SB(b, h) ((4 + (b) * 2 + (h)) * HTB)
#define PG8_STAGE(bufoff, gbase, voff) do { _Pragma("unroll") for (int _i = 0; _i < 2; ++_i) \
        __builtin_amdgcn_global_load_lds((const unsigned*)((const char*)(gbase) + (voff)[_i]), (PG8_LAS unsigned*)(lds + (bufoff) + ldsw + _i * 8192), 16, 0, 0); } while (0)
#define PG8_LDA(dst, b, h) do { _Pragma("unroll") for (int m = 0; m < 4; ++m) _Pragma("unroll") for (int k = 0; k < 2; ++k) dst[m][k] = *(const PG8_LAS bf16x8*)(lds + PG8_SA(b, h) + aoff + m * 2048 + k * 1024); } while (0)
#define PG8_LDB(dst, b, h) do { _Pragma("unroll") for (int n = 0; n < 2; ++n) _Pragma("unroll") for (int k = 0; k < 2; ++k) dst[n][k] = *(const PG8_LAS bf16x8*)(lds + PG8_SB(b, h) + boff + n * 2048 + k * 1024); } while (0)
#define PG8_MMA(ai, bj, At, Bt) do { __builtin_amdgcn_s_setprio(1); _Pragma("unroll") for (int m = 0; m < 4; ++m) _Pragma("unroll") for (int n = 0; n < 2; ++n) _Pragma("unroll") for (int k = 0; k < 2; ++k) \
        acc[ai][bj][m][n] = __builtin_amdgcn_mfma_f32_16x16x32_bf16(Bt[n][k], At[m][k], acc[ai][bj][m][n], 0, 0, 0); __builtin_amdgcn_s_setprio(0); } while (0)
#define PG8_WAIT_V(n) asm volatile("s_waitcnt vmcnt(" #n ")" ::: "memory")
#define PG8_WAIT_L(n) asm volatile("s_waitcnt lgkmcnt(" #n ")" ::: "memory")
#define PG8_BAR __builtin_amdgcn_s_barrier()
#define PG8_SCHED __builtin_amdgcn_sched_barrier(0)
    Unit cur, nxt; int ui = 0;
    if (!S.next(0, cur)) return;
    f32x4 acc[2][2][4][2];
#pragma unroll
    for (int a = 0; a < 2; ++a)
#pragma unroll
        for (int b = 0; b < 2; ++b)
#pragma unroll
            for (int m = 0; m < 4; ++m)
#pragma unroll
                for (int n = 0; n < 2; ++n) acc[a][b][m][n] = (f32x4){0.f, 0.f, 0.f, 0.f};
    bf16x8 At[4][2], B0[2][2], B1[2][2];
    const char* cA = (const char*)g.A + (size_t)cur.pm * tstep; const char* cB = (const char*)g.Bt + (size_t)cur.pn * tstep;
    S.a_ready(cur);
    if constexpr (SP2) {
        PG8_STAGE(PG8_SB(0, 0), cB, voffB); PG8_STAGE(PG8_SB(0, 1), cB + hstep, voffB); PG8_STAGE(PG8_SA(0, 0), cA, voffA); PG8_STAGE(PG8_SA(0, 1), cA + hstep, voffA);
        if (wr == 1) PG8_BAR;
        PG8_WAIT_V(2); PG8_BAR;
        PG8_STAGE(PG8_SB(1, 0), cB + kstep, voffB); PG8_STAGE(PG8_SA(1, 0), cA + kstep, voffA); PG8_STAGE(PG8_SB(1, 1), cB + hstep + kstep, voffB);
        PG8_WAIT_V(6); PG8_BAR;
    } else {
        PG8_STAGE(PG8_SB(0, 0), cB, voffB); PG8_STAGE(PG8_SA(0, 0), cA, voffA); PG8_STAGE(PG8_SB(0, 1), cB + hstep, voffB); PG8_STAGE(PG8_SA(0, 1), cA + hstep, voffA);
        if (wr == 1) PG8_BAR;
        PG8_WAIT_V(4); PG8_BAR;
        PG8_STAGE(PG8_SB(1, 0), cB + kstep, voffB); PG8_STAGE(PG8_SA(1, 0), cA + kstep, voffA); PG8_STAGE(PG8_SB(1, 1), cB + hstep + kstep, voffB);
        PG8_WAIT_V(6); PG8_BAR;
    }
    for (;;) {
        const bool has_next = S.next(ui + 1, nxt);
        const char* nA = has_next ? (const char*)g.A + (size_t)nxt.pm * tstep : cA; const char* nB = has_next ? (const char*)g.Bt + (size_t)nxt.pn * tstep : cB;
        for (int t = 0; t < nt; t += 2) {
            const bool last = (t == nt - 2);
            const char* a1 = cA + (size_t)(t + 1) * kstep;
            const char* a2 = last ? nA : cA + (size_t)(t + 2) * kstep; const char* b2 = last ? nB : cB + (size_t)(t + 2) * kstep;
            const char* a3 = a2 + kstep; const char* b3 = b2 + kstep;
            if (last && has_next) S.a_ready(nxt);
            if constexpr (SP2) {
            PG8_LDB(B0, 0, 0); PG8_LDB(B1, 0, 1); PG8_SCHED; PG8_LDA(At, 0, 0); PG8_STAGE(PG8_SA(1, 1), a1 + hstep, voffA);
            PG8_WAIT_V(8); PG8_WAIT_L(0); PG8_BAR; PG8_MMA(0, 0, At, B0); PG8_MMA(0, 1, At, B1); PG8_BAR; PG8_SCHED;
            PG8_LDA(At, 0, 1); PG8_STAGE(PG8_SB(0, 0), b2, voffB); PG8_STAGE(PG8_SB(0, 1), b2 + hstep, voffB); PG8_STAGE(PG8_SA(0, 0), a2, voffA);
            PG8_WAIT_V(8); PG8_WAIT_L(0); PG8_BAR; PG8_MMA(1, 0, At, B0); PG8_MMA(1, 1, At, B1); PG8_BAR; PG8_SCHED;
            PG8_LDB(B0, 1, 0); PG8_LDB(B1, 1, 1); PG8_SCHED; PG8_LDA(At, 1, 0); PG8_STAGE(PG8_SA(0, 1), a2 + hstep, voffA);
            PG8_WAIT_V(8); PG8_WAIT_L(0); PG8_BAR; PG8_MMA(0, 0, At, B0); PG8_MMA(0, 1, At, B1); PG8_BAR; PG8_SCHED;
            PG8_LDA(At, 1, 1); PG8_STAGE(PG8_SB(1, 0), b3, voffB); PG8_STAGE(PG8_SB(1, 1), b3 + hstep, voffB); PG8_STAGE(PG8_SA(1, 0), a3, voffA);
            PG8_WAIT_V(8); PG8_WAIT_L(0); PG8_BAR; PG8_MMA(1, 0, At, B0); PG8_MMA(1, 1, At, B1); PG8_BAR; PG8_SCHED;
            } else {
            PG8_LDB(B0, 0, 0); PG8_SCHED; PG8_LDA(At, 0, 0); PG8_STAGE(PG8_SA(1, 1), a1 + hstep, voffA);
            PG8_WAIT_L(8); PG8_BAR; PG8_WAIT_L(0); PG8_MMA(0, 0, At, B0); PG8_BAR; PG8_SCHED;
            PG8_LDB(B1, 0, 1); PG8_STAGE(PG8_SB(0, 0), b2, voffB);
            PG8_BAR; PG8_WAIT_L(0); PG8_MMA(0, 1, At, B1); PG8_BAR;
            PG8_LDA(At, 0, 1); PG8_STAGE(PG8_SA(0, 0), a2, voffA);
            PG8_BAR; PG8_WAIT_L(0); PG8_MMA(1, 0, At, B0); PG8_BAR; PG8_SCHED;
            PG8_STAGE(PG8_SB(0, 1), b2 + hstep, voffB);
            PG8_WAIT_V(6); PG8_BAR; PG8_MMA(1, 1, At, B1); PG8_BAR;
            PG8_LDB(B0, 1, 0); PG8_SCHED; PG8_LDA(At, 1, 0); PG8_STAGE(PG8_SA(0, 1), a2 + hstep, voffA);
            PG8_WAIT_L(8); PG8_BAR; PG8_WAIT_L(0); PG8_MMA(0, 0, At, B0); PG8_BAR; PG8_SCHED;
            PG8_LDB(B1, 1, 1); PG8_STAGE(PG8_SB(1, 0), b3, voffB);
            PG8_BAR; PG8_WAIT_L(0); PG8_MMA(0, 1, At, B1); PG8_BAR;
            PG8_LDA(At, 1, 1); PG8_STAGE(PG8_SA(1, 0), a3, voffA);
            PG8_BAR; PG8_WAIT_L(0); PG8_MMA(1, 0, At, B0); PG8_BAR; PG8_SCHED;
            PG8_STAGE(PG8_SB(1, 1), b3 + hstep, voffB);
            PG8_WAIT_V(6); PG8_BAR; PG8_MMA(1, 1, At, B1); PG8_BAR;
            }
        }
        if constexpr (ALIGN_EPI) { if (wr == 0) PG8_BAR; }
        if constexpr (!Epi::AFTER_DRAIN) { E(acc, cur, wr, wc, fr, fq); S.done(cur); }
        if (!has_next) break;
#pragma unroll
        for (int a = 0; a < 2; ++a)
#pragma unroll
            for (int b = 0; b < 2; ++b)
#pragma unroll
                for (int m = 0; m < 4; ++m)
#pragma unroll
                    for (int n = 0; n < 2; ++n) acc[a][b][m][n] = (f32x4){0.f, 0.f, 0.f, 0.f};
        cur = nxt; cA = nA; cB = nB; ++ui;
        if constexpr (ALIGN_EPI) { if (wr == 1) PG8_BAR; }
    }
    PG8_WAIT_V(0);
    if constexpr (!ALIGN_EPI) { if (wr == 0) PG8_BAR; }
    PG8_BAR;
    if constexpr (Epi::AFTER_DRAIN) { E.fused(acc, cur, wr, wc, fr, fq, lds, wid, lane); S.done(cur); }
#undef PG8_SA
#undef PG8_SB
#undef PG8_STAGE
#undef PG8_LDA
#undef PG8_LDB
#undef PG8_MMA
#undef PG8_WAIT_V
#undef PG8_WAIT_L
#undef PG8_BAR
#undef PG8_SCHED
}
}

#define DI __device__ __forceinline__
#define GAS __attribute__((address_space(1)))
#define LAS __attribute__((address_space(3)))
typedef unsigned short bf16;
typedef unsigned v4u __attribute__((ext_vector_type(4)));
typedef unsigned v2u __attribute__((ext_vector_type(2)));
typedef float f32x2 __attribute__((ext_vector_type(2)));
typedef float f32x4 __attribute__((ext_vector_type(4)));
typedef float f32x8 __attribute__((ext_vector_type(8)));
typedef float f32x16 __attribute__((ext_vector_type(16)));
typedef short bf16x8 __attribute__((ext_vector_type(8)));
typedef short bf16x4 __attribute__((ext_vector_type(4)));
typedef __bf16 bf16x8n __attribute__((ext_vector_type(8)));
typedef __bf16 bf16x4n __attribute__((ext_vector_type(4)));
typedef __bf16 bf16x2n __attribute__((ext_vector_type(2)));
typedef GAS unsigned gu32;
#define RLX_AGENT __ATOMIC_RELAXED, __HIP_MEMORY_SCOPE_AGENT
#define LDS_WAIT() asm volatile("s_waitcnt lgkmcnt(0)" ::: "memory")
#define VM_WAIT() asm volatile("s_waitcnt vmcnt(0)" ::: "memory")

constexpr int NWAVES = 8;
constexpr int T = 16896, TP = 16384, D = 1024, DFF = 2816, NIN = 2560, NCHUNK = 264, NITEM = 1056;
constexpr float LN_EPS = 1e-5f, RMS_EPS = 1e-6f, ALPHA = 1.18920711500272f;
enum { I_XP = 0, I_XS, I_S5RE, I_S5IM, I_SGDN, I_CONV, I_CP, I_CS, I_WADA, I_BADA, I_WIN, I_ARE, I_AIM, I_LOGDT, I_BRE, I_BIM, I_CRE, I_CIM, I_S5D, I_WGLU,
       I_CONVW, I_ALOG, I_DTB, I_NORMG, I_WOUT, I_LN1G, I_LN1B, I_WUP, I_WDOWN, I_LN2G, I_LN2B, N_IN };
constexpr size_t O_Y = 0, O_S5RE_P = 17301504, O_S5IM_P = O_S5RE_P + 8192, O_GDN_P = O_S5IM_P + 8192, O_CONV_P = O_GDN_P + 262144,
                 O_S5RE_S = O_CONV_P + 18432, O_S5IM_S = O_S5RE_S + 16384, O_GDN_S = O_S5IM_S + 16384, O_CONV_S = O_GDN_S + 524288, O_END = O_CONV_S + 36864;
static_assert(O_END == 18192384, "output size");
constexpr size_t MiB = 1u << 20, KiB = 1024;
constexpr size_t WS_CTL = 0, CTL_ZERO_BYTES = 1 * MiB;
constexpr int CW_BAR = 4096;
constexpr size_t WS_MOD = 256 * KiB;
constexpr size_t WS_MISC = 1 * MiB;
constexpr size_t MISC_S5AB = 0, MISC_BF = 32 * KiB, MISC_CF = 160 * KiB, MISC_WX = 288 * KiB, MISC_GL = 320 * KiB;
constexpr size_t WS_WIN = 2 * MiB, WS_WGLU = 7 * MiB, WS_WOUT = 8 * MiB, WS_WUP = 10 * MiB, WS_WDOWN = 21 * MiB;
constexpr size_t WS_BA = 27 * MiB, WS_E = 28 * MiB, WS_XN = 34 * MiB;
constexpr size_t PSZ = (size_t)T * 512 * 2;
constexpr size_t WS_PROJ = 67 * MiB, WS_PU = WS_PROJ, WS_PQ = WS_PROJ + PSZ, WS_PK = WS_PROJ + 2 * PSZ, WS_PV = WS_PROJ + 3 * PSZ, WS_PZ = WS_PROJ + 4 * PSZ;
constexpr size_t WS_OBUF = WS_PQ, WS_YA = WS_PV, WS_MIX = WS_XN, WS_X1 = WS_PROJ;
constexpr size_t WS_GDN = 150 * MiB, GDN_ITEM = 90112, WS_HID = WS_GDN;
constexpr size_t G_U = 0, G_WN = 32768, G_QD = 49152, G_QK = 65536, G_KD = 73728;
constexpr size_t WS_END = 241 * MiB;
static_assert(WS_PROJ + 5 * PSZ <= WS_GDN && WS_GDN + NITEM * GDN_ITEM <= WS_END && WS_HID + (size_t)T * DFF * 2 <= WS_END && WS_XN + (size_t)T * D * 2 <= WS_PROJ, "ws map");
static_assert(WS_X1 + (size_t)T * D * 4 <= WS_PZ, "X1 overlay");
constexpr int RING_BYTES = 131072, LDSCTL_OFF = RING_BYTES, MISC_OFF = LDSCTL_OFF + 320, LDS_BYTES = 147456;

DI float bf2f(unsigned short b) { return __uint_as_float((unsigned)b << 16); }
DI unsigned pk2(float lo, float hi) { f32x2 v = {lo, hi}; return __builtin_bit_cast(unsigned, __builtin_convertvector(v, bf16x2n)); }
DI unsigned short f2bf(float x) { return (unsigned short)(pk2(x, 0.f) & 0xffffu); }
DI bf16x8 pack8(const f32x16& x, const int s) {
    f32x8 v;
#pragma unroll
    for (int j = 0; j < 8; ++j) v[j] = x[8 * s + j];
    return __builtin_bit_cast(bf16x8, __builtin_convertvector(v, bf16x8n));
}
DI float wave_sum(float v) {
#pragma unroll
    for (int o = 1; o < 64; o <<= 1) v += __shfl_xor(v, o);
    return v;
}
DI int crow(int reg, int h) { return (reg & 3) + 8 * (reg >> 2) + 4 * h; }
#define MFMA32(a, b, c) __builtin_amdgcn_mfma_f32_32x32x16_bf16((a), (b), (c), 0, 0, 0)
#define MFMA16(a, b, c) __builtin_amdgcn_mfma_f32_16x16x32_bf16((a), (b), (c), 0, 0, 0)

struct Args { const float* in[N_IN]; float* out; unsigned char* ws; int ph_lo, ph_hi; };

DI int seq_of_row(int row) { return row < TP ? (row >> 12) : 4 + ((row - TP) >> 6); }

DI void p0_transpose_item(const float* W, int K, int N, bf16* WT, int n0s, int n0d, int k0, LAS float* scr, int lane) {
#pragma unroll 8
    for (int i = 0; i < 32; ++i) { const int kk = 2 * i + (lane >> 5); scr[kk * 33 + (lane & 31)] = W[(size_t)(k0 + kk) * N + n0s + (lane & 31)]; }
    LDS_WAIT(); asm volatile("" ::: "memory");
    const int c = lane & 7;
#pragma unroll
    for (int j = 0; j < 4; ++j) { const int n = (lane >> 3) + 8 * j; const LAS float* s = scr + (8 * c) * 33 + n;
        v4u o; o.x = pk2(s[0 * 33], s[1 * 33]); o.y = pk2(s[2 * 33], s[3 * 33]); o.z = pk2(s[4 * 33], s[5 * 33]); o.w = pk2(s[6 * 33], s[7 * 33]);
        *(GAS v4u*)(WT + (size_t)(n0d + n) * K + k0 + 8 * c) = o; }
    LDS_WAIT(); asm volatile("" ::: "memory");
}
DI void phase0(const Args& a, LAS unsigned char* L, int tid, int lane, int wave, int gw, int NGW) {
    unsigned char* ws = a.ws;
    LAS float* scT = (LAS float*)L;
    for (int i = tid; i < 12 * 1024; i += NWAVES * 64) { const int s = i >> 10, k = i & 1023; const float c = s < 4 ? a.in[I_CP][s * 1024 + k] : a.in[I_CS][(s - 4) * 1024 + k];
        scT[k * 12 + s] = c / (1.0f + expf(-c)); }
    __syncthreads();
    LAS float* scr = (LAS float*)(L + 49152 + wave * 8448);
    constexpr int N_ADA = 384, N_S5 = 32, N_WX = 8;
    constexpr int I_WINT = (D / 64) * (NIN / 32), I_GLU = (512 / 64) * (1024 / 32), I_OUT = (D / 64) * (D / 32), I_UP = (D / 64) * (2 * DFF / 32), I_DOWN = (DFF / 64) * (D / 32);
    constexpr int NITEMS = N_ADA + N_S5 + N_WX + I_WINT + I_GLU + I_OUT + I_UP + I_DOWN;
    for (int it0 = gw; it0 < NITEMS; it0 += NGW) {
        int it = it0;
        if (it < N_ADA) {
            const int cb = it >> 4, kc = it & 15;
            f32x4 acc[12];
#pragma unroll
            for (int s = 0; s < 12; ++s) acc[s] = (f32x4){0.f, 0.f, 0.f, 0.f};
            const float* wp = a.in[I_WADA] + (size_t)(kc * 64) * 6144 + cb * 256 + 4 * lane;
#pragma unroll 4
            for (int kk = 0; kk < 64; ++kk) { const f32x4 w = *(const f32x4*)(wp + (size_t)kk * 6144);
                const LAS f32x4* sp = (const LAS f32x4*)(scT + (kc * 64 + kk) * 12); const f32x4 s0 = sp[0], s1 = sp[1], s2 = sp[2];
                acc[0] += w * s0.x; acc[1] += w * s0.y; acc[2] += w * s0.z; acc[3] += w * s0.w; acc[4] += w * s1.x; acc[5] += w * s1.y; acc[6] += w * s1.z; acc[7] += w * s1.w;
                acc[8] += w * s2.x; acc[9] += w * s2.y; acc[10] += w * s2.z; acc[11] += w * s2.w; }
            if (kc == 0) { const f32x4 b = *(const f32x4*)(a.in[I_BADA] + cb * 256 + 4 * lane);
#pragma unroll
                for (int s = 0; s < 12; ++s) acc[s] += b; }
            float* mod = (float*)(ws + WS_MOD) + cb * 256 + 4 * lane;
#pragma unroll
            for (int s = 0; s < 12; ++s)
#pragma unroll
                for (int e = 0; e < 4; ++e) (void)__hip_atomic_fetch_add(mod + s * 6144 + e, acc[s][e], RLX_AGENT);
            continue;
        }
        it -= N_ADA;
        if (it < N_S5) {
            const int g = it, p = lane;
            const float are = a.in[I_ARE][g * 64 + p], aim = a.in[I_AIM][g * 64 + p], dt = expf(a.in[I_LOGDT][g]);
            const float mag = expf(are * dt), ang = aim * dt, abr = mag * cosf(ang), abi = mag * sinf(ang);
            const float mag64 = expf(64.0f * are * dt), ang64 = 64.0f * ang, a64r = mag64 * cosf(ang64), a64i = mag64 * sinf(ang64);
            const float den = are * are + aim * aim, nr = abr - 1.0f, ni = abi;
            const float fr = (nr * are + ni * aim) / den, fi = (ni * are - nr * aim) / den;
            ((f32x4*)(ws + WS_MISC + MISC_S5AB))[g * 64 + p] = (f32x4){abr, abi, a64r, a64i};
            const float* bre = a.in[I_BRE] + (size_t)(g * 64 + p) * 16; const float* bim = a.in[I_BIM] + (size_t)(g * 64 + p) * 16;
            float Br[16], Bi[16];
#pragma unroll
            for (int i = 0; i < 16; ++i) { const float br = bre[i], bi = bim[i]; Br[i] = fr * br - fi * bi; Bi[i] = fr * bi + fi * br; }
            v4u* BF = (v4u*)(ws + WS_MISC + MISC_BF);
            const int n = p & 31, tre = p >> 5, tim = 2 + (p >> 5);
#pragma unroll
            for (int kh = 0; kh < 2; ++kh) {
                v4u o; o.x = pk2(Br[8 * kh + 0], Br[8 * kh + 1]); o.y = pk2(Br[8 * kh + 2], Br[8 * kh + 3]); o.z = pk2(Br[8 * kh + 4], Br[8 * kh + 5]); o.w = pk2(Br[8 * kh + 6], Br[8 * kh + 7]);
                BF[(g * 4 + tre) * 64 + n + 32 * kh] = o;
                o.x = pk2(Bi[8 * kh + 0], Bi[8 * kh + 1]); o.y = pk2(Bi[8 * kh + 2], Bi[8 * kh + 3]); o.z = pk2(Bi[8 * kh + 4], Bi[8 * kh + 5]); o.w = pk2(Bi[8 * kh + 6], Bi[8 * kh + 7]);
                BF[(g * 4 + tim) * 64 + n + 32 * kh] = o; }
            v4u* CF = (v4u*)(ws + WS_MISC + MISC_CF);
            const int j = lane & 15, kq = lane >> 4;
            const float* cre = a.in[I_CRE] + (size_t)(g * 16 + j) * 64; const float* cim = a.in[I_CIM] + (size_t)(g * 16 + j) * 64;
#pragma unroll
            for (int s = 0; s < 4; ++s) { float v[8];
#pragma unroll
                for (int jj = 0; jj < 8; ++jj) { const int kidx = 32 * s + 8 * kq + jj, p32 = kidx >> 2, c4 = kidx & 3, pp = p32 + ((c4 & 2) ? 32 : 0); v[jj] = (c4 & 1) ? -cim[pp] : cre[pp]; }
                v4u o; o.x = pk2(v[0], v[1]); o.y = pk2(v[2], v[3]); o.z = pk2(v[4], v[5]); o.w = pk2(v[6], v[7]);
                CF[(g * 4 + s) * 64 + lane] = o; }
            continue;
        }
        it -= N_S5;
        if (it < N_WX) {
            float* WX = (float*)(ws + WS_MISC + MISC_WX);
            for (int i = 0; i < 16; ++i) { const int k = lane + 64 * i; WX[it * 1024 + k] = a.in[I_WIN][(size_t)k * 2568 + 2560 + it]; }
            continue;
        }
        it -= N_WX;
        if (it < I_WINT) { const int nblk = NIN / 32, kb = it / nblk, nb = it % nblk; p0_transpose_item(a.in[I_WIN], D, 2568, (bf16*)(ws + WS_WIN), 32 * nb, 32 * nb, 64 * kb, scr, lane); continue; }
        it -= I_WINT;
        if (it < I_GLU) { const int nblk = 1024 / 32, kb = it / nblk, nb = it % nblk, nd = 32 * nb, ns = ((nd >> 7) & 1) * 512 + (nd >> 8) * 128 + (nd & 127);
            p0_transpose_item(a.in[I_WGLU], 512, 1024, (bf16*)(ws + WS_WGLU), ns, nd, 64 * kb, scr, lane); continue; }
        it -= I_GLU;
        if (it < I_OUT) { const int nblk = D / 32, kb = it / nblk, nb = it % nblk; p0_transpose_item(a.in[I_WOUT], D, D, (bf16*)(ws + WS_WOUT), 32 * nb, 32 * nb, 64 * kb, scr, lane); continue; }
        it -= I_OUT;
        if (it < I_UP) { const int nblk = 2 * DFF / 32, kb = it / nblk, nb = it % nblk, nd = 32 * nb, ns = ((nd >> 7) & 1) * DFF + (nd >> 8) * 128 + (nd & 127);
            p0_transpose_item(a.in[I_WUP], D, 2 * DFF, (bf16*)(ws + WS_WUP), ns, nd, 64 * kb, scr, lane); continue; }
        it -= I_UP;
        { const int nblk = D / 32, kb = it / nblk, nb = it % nblk; p0_transpose_item(a.in[I_WDOWN], DFF, D, (bf16*)(ws + WS_WDOWN), 32 * nb, 32 * nb, 64 * kb, scr, lane); }
    }
}

DI void phase1(const Args& a, LAS unsigned char* L, int tid, int lane, int gw, int NGW) {
    unsigned char* ws = a.ws;
    LAS float* wx = (LAS float*)L;
    { const float* WXg = (const float*)(ws + WS_MISC + MISC_WX); for (int i = tid; i < 8192; i += NWAVES * 64) wx[i] = WXg[i]; }
    __syncthreads();
    const float* mod = (const float*)(ws + WS_MOD);
    for (int row = gw; row < T; row += NGW) {
        const float* xr = row < TP ? a.in[I_XP] + (size_t)row * D : a.in[I_XS] + (size_t)(row - TP) * D;
        const float* md = mod + seq_of_row(row) * 6144;
        f32x4 v[4]; float s = 0.f;
#pragma unroll
        for (int j = 0; j < 4; ++j) { v[j] = *(const f32x4*)(xr + 4 * lane + 256 * j); s += (v[j].x + v[j].y) + (v[j].z + v[j].w); }
        const float mean = wave_sum(s) * (1.f / D); float s2 = 0.f;
#pragma unroll
        for (int j = 0; j < 4; ++j) { v[j] = v[j] - mean; s2 += (v[j].x * v[j].x + v[j].y * v[j].y) + (v[j].z * v[j].z + v[j].w * v[j].w); }
        const float rstd = 1.f / sqrtf(wave_sum(s2) * (1.f / D) + LN_EPS);
        bf16* orow = (bf16*)(ws + WS_XN) + (size_t)row * D;
#pragma unroll
        for (int j = 0; j < 4; ++j) { const int col = 4 * lane + 256 * j; const f32x4 sh = *(const f32x4*)(md + col), sc = *(const f32x4*)(md + 1024 + col);
            v[j] = v[j] * rstd * (sc + 1.0f) + sh;
            v2u o; o.x = pk2(v[j].x, v[j].y); o.y = pk2(v[j].z, v[j].w); *(v2u*)(orow + col) = o; }
        float d[8];
#pragma unroll
        for (int c = 0; c < 8; ++c) { float acc = 0.f;
#pragma unroll
            for (int j = 0; j < 4; ++j) { const f32x4 w = *(const LAS f32x4*)(wx + c * 1024 + 4 * lane + 256 * j); acc += (v[j].x * w.x + v[j].y * w.y) + (v[j].z * w.z + v[j].w * w.w); }
            d[c] = wave_sum(acc); }
        float ov = d[0];
#pragma unroll
        for (int c = 1; c < 8; ++c) ov = lane == c ? d[c] : ov;
        if (lane < 8) ((float*)(ws + WS_BA))[(size_t)row * 8 + lane] = ov;
    }
}

constexpr int GP_KS = 0, GP_QS = 17408, GP_VS = 34816, GP_WF = 67584, GP_AS = 101376, GP_QK = 117760, GP_DEC = 126976, WF_LD = 132;
DI void gdn_prep_item(const Args& a, LAS unsigned char* L, int item, int tid, int lane, int wave) {
    unsigned char* ws = a.ws;
    asm volatile("" : "+v"(L), "+v"(tid), "+v"(lane));
    const int c = item >> 2, h = item & 3;
    const int seq = c < 256 ? (c >> 6) : 4 + (c - 256), cis = c < 256 ? (c & 63) : 0, row0 = 64 * c;
    const bool last_chunk = c < 256 ? (cis == 63) : true;
    LAS bf16* Ks = (LAS bf16*)(L + GP_KS); LAS bf16* Qs = (LAS bf16*)(L + GP_QS); LAS float* Wf = (LAS float*)(L + GP_WF);
    LAS float* Vs = (LAS float*)(L + GP_VS); LAS float* As = (LAS float*)(L + GP_AS); LAS bf16* QKs = (LAS bf16*)(L + GP_QK);
    LAS float* dec = (LAS float*)(L + GP_DEC); LAS float* betas = dec + 64; LAS float* edec = dec + 128; LAS float* edl = dec + 192;
    unsigned char* gbase = ws + WS_GDN + (size_t)item * GDN_ITEM;
    {
        const int t0 = 8 * wave, ch = h * 128 + 2 * lane;
#pragma unroll
        for (int which = 0; which < 3; ++which) {
            const bf16* src = (const bf16*)(ws + WS_PQ + (size_t)which * PSZ);
            float x[11][2];
#pragma unroll
            for (int i = 0; i < 11; ++i) { const int t = t0 - 3 + i;
                if (t >= 0 || cis > 0) { const unsigned u = *(const unsigned*)(src + (size_t)(row0 + t) * 512 + ch); x[i][0] = bf2f((unsigned short)(u & 0xffffu)); x[i][1] = bf2f((unsigned short)(u >> 16)); }
                else if (seq >= 4) { const f32x2 cv = *(const f32x2*)(a.in[I_CONV] + (size_t)((seq - 4) * 3 + (3 + t)) * 1536 + which * 512 + ch); x[i][0] = cv.x; x[i][1] = cv.y; }
                else { x[i][0] = 0.f; x[i][1] = 0.f; } }
            float cw[4][2];
#pragma unroll
            for (int j = 0; j < 4; ++j) { const f32x2 w2 = *(const f32x2*)(a.in[I_CONVW] + (size_t)j * 1536 + which * 512 + ch); cw[j][0] = w2.x; cw[j][1] = w2.y; }
#pragma unroll
            for (int tt = 0; tt < 8; ++tt) {
                float y0 = 0.f, y1 = 0.f;
#pragma unroll
                for (int j = 0; j < 4; ++j) { y0 += cw[j][0] * x[tt + j][0]; y1 += cw[j][1] * x[tt + j][1]; }
                y0 = y0 / (1.0f + __expf(-y0)); y1 = y1 / (1.0f + __expf(-y1));
                if (which < 2) { const float ss = wave_sum(y0 * y0 + y1 * y1); const float sc = (which == 0 ? 0.08838834764831845f : 1.0f) / sqrtf(ss + RMS_EPS);
                    *(LAS unsigned*)((which == 0 ? Qs : Ks) + (t0 + tt) * 136 + 2 * lane) = pk2(y0 * sc, y1 * sc); }
                else *(LAS f32x2*)(Vs + (t0 + tt) * 128 + 2 * lane) = (f32x2){y0, y1};
            }
            if (last_chunk && wave == 7) {
                float* co = a.out + (seq < 4 ? O_CONV_P + (size_t)seq * 3 * 1536 : O_CONV_S + (size_t)(seq - 4) * 3 * 1536) + which * 512 + ch;
#pragma unroll
                for (int j = 0; j < 3; ++j) *(f32x2*)(co + (size_t)j * 1536) = (f32x2){x[8 + j][0], x[8 + j][1]};
            }
        }
    }
    if (wave == 0) {
        const float* BA = (const float*)(ws + WS_BA) + (size_t)(row0 + lane) * 8;
        const float braw = BA[h], araw = BA[4 + h];
        const float beta = 1.0f / (1.0f + expf(-braw));
        const float xx = araw + a.in[I_DTB][h]; const float sp = xx > 20.f ? xx : log1pf(expf(xx));
        float g = -expf(a.in[I_ALOG][h]) * sp;
#pragma unroll
        for (int o = 1; o < 64; o <<= 1) { const float t = __shfl_up(g, o); if (lane >= o) g += t; }
        const float dl = __shfl(g, 63);
        dec[lane] = g; betas[lane] = beta; edec[lane] = expf(g); edl[lane] = expf(dl - g);
        if (lane == 0) ((float*)(ws + WS_MISC + MISC_GL))[item] = expf(dl);
    }
    __syncthreads();
    {
        const int mat = wave >> 2, ti = wave & 3, r16 = lane & 15, kq = lane >> 4;
        const LAS bf16* Asrc = mat ? Qs : Ks;
        bf16x8 afr[4];
#pragma unroll
        for (int s = 0; s < 4; ++s) afr[s] = *(const LAS bf16x8*)(Asrc + (16 * ti + r16) * 136 + 32 * s + 8 * kq);
        for (int tj = 0; tj < 4; ++tj) {
            f32x4 acc = (f32x4){0.f, 0.f, 0.f, 0.f};
            if (tj <= ti) {
#pragma unroll
                for (int s = 0; s < 4; ++s) { const bf16x8 b = *(const LAS bf16x8*)(Ks + (16 * tj + r16) * 136 + 32 * s + 8 * kq); acc = MFMA16(afr[s], b, acc); }
            }
            const int j = 16 * tj + r16; const float dj = dec[j];
#pragma unroll
            for (int reg = 0; reg < 4; ++reg) { const int i = 16 * ti + 4 * kq + reg;
                if (mat == 0) { const float v = (j < i) ? betas[i] * acc[reg] * expf(dec[i] - dj) : 0.f; As[i * 64 + j] = v; }
                else { const float v = (j <= i) ? acc[reg] * expf(dec[i] - dj) : 0.f; QKs[i * 72 + j] = f2bf(v); } }
        }
    }
    __syncthreads();
    if (wave < 4) {
        const int cc = tid & 127; const bool is_u = wave < 2;
        LAS float* Xs = is_u ? Vs : Wf; const int xld = is_u ? 128 : WF_LD;
#pragma unroll 1
        for (int b = 0; b < 4; ++b) {
            float acc[16];
            if (is_u) {
#pragma unroll
                for (int r = 0; r < 16; ++r) acc[r] = Vs[(16 * b + r) * 128 + cc] * betas[16 * b + r];
            } else {
#pragma unroll
                for (int r = 0; r < 16; ++r) acc[r] = bf2f(Ks[(16 * b + r) * 136 + cc]) * (betas[16 * b + r] * edec[16 * b + r]);
            }
#pragma unroll 1
            for (int j = 0; j < 16 * b; j += 4) {
                const float x0 = Xs[j * xld + cc], x1 = Xs[(j + 1) * xld + cc], x2 = Xs[(j + 2) * xld + cc], x3 = Xs[(j + 3) * xld + cc];
#pragma unroll
                for (int r = 0; r < 16; ++r) { const f32x4 av = *(const LAS f32x4*)(As + (16 * b + r) * 64 + j); acc[r] -= (av.x * x0 + av.y * x1) + (av.z * x2 + av.w * x3); }
            }
#pragma unroll
            for (int r = 1; r < 16; ++r) {
#pragma unroll
                for (int j4 = 0; j4 < (r + 3) / 4; ++j4) { const f32x4 av = *(const LAS f32x4*)(As + (16 * b + r) * 64 + 16 * b + 4 * j4);
#pragma unroll
                    for (int e = 0; e < 4; ++e) if (4 * j4 + e < r) acc[r] -= av[e] * acc[4 * j4 + e]; }
            }
#pragma unroll
            for (int r = 0; r < 16; ++r) Xs[(16 * b + r) * xld + cc] = acc[r];
        }
    } else {
        const int t2 = tid - 256;
#pragma unroll
        for (int q = 0; q < 4; ++q) { const int chunk = t2 + 256 * q, fl = chunk & 63, s = (chunk >> 6) & 7, mt = chunk >> 9, tok = 32 * mt + (fl & 31), hh = fl >> 5;
            const bf16x4 p0 = *(const LAS bf16x4*)(Qs + tok * 136 + 16 * s + 4 * hh), p1 = *(const LAS bf16x4*)(Qs + tok * 136 + 16 * s + 8 + 4 * hh); const float e = edec[tok];
            v4u o; o.x = pk2(bf2f(p0[0]) * e, bf2f(p0[1]) * e); o.y = pk2(bf2f(p0[2]) * e, bf2f(p0[3]) * e); o.z = pk2(bf2f(p1[0]) * e, bf2f(p1[1]) * e); o.w = pk2(bf2f(p1[2]) * e, bf2f(p1[3]) * e);
            ((v4u*)(gbase + G_QD))[chunk] = o; }
#pragma unroll
        for (int q = 0; q < 2; ++q) { const int chunk = t2 + 256 * q, fl = chunk & 63, k4 = (chunk >> 6) & 3, mt = chunk >> 8, i = 32 * mt + (fl & 31), hh = fl >> 5;
            const v2u p0 = *(const LAS v2u*)(QKs + i * 72 + 16 * k4 + 4 * hh), p1 = *(const LAS v2u*)(QKs + i * 72 + 16 * k4 + 8 + 4 * hh);
            ((v4u*)(gbase + G_QK))[chunk] = (v4u){p0.x, p0.y, p1.x, p1.y}; }
#pragma unroll
        for (int q = 0; q < 4; ++q) { const int chunk = t2 + 256 * q, fl = chunk & 63, k4 = (chunk >> 6) & 3, mtk = chunk >> 8, dk = 32 * mtk + (fl & 31), hh = fl >> 5;
            float v[8];
#pragma unroll
            for (int j = 0; j < 8; ++j) { const int tok = 16 * k4 + 8 * (j >> 2) + 4 * hh + (j & 3); v[j] = bf2f(Ks[tok * 136 + dk]) * edl[tok]; }
            v4u o; o.x = pk2(v[0], v[1]); o.y = pk2(v[2], v[3]); o.z = pk2(v[4], v[5]); o.w = pk2(v[6], v[7]);
            ((v4u*)(gbase + G_KD))[chunk] = o; }
    }
    __syncthreads();
    if (wave < 2) {
        const int dv = tid & 127, sl = dv >> 5, l32 = dv & 31;
        f32x4* U4 = (f32x4*)(gbase + G_U);
#pragma unroll
        for (int mt = 0; mt < 2; ++mt)
#pragma unroll
            for (int q = 0; q < 4; ++q)
#pragma unroll
                for (int hf = 0; hf < 2; ++hf) { const int tb = 32 * mt + 8 * q + 4 * hf;
                    U4[(((sl * 2 + mt) * 4 + q) * 2 + hf) * 32 + l32] = (f32x4){Vs[tb * 128 + dv], Vs[(tb + 1) * 128 + dv], Vs[(tb + 2) * 128 + dv], Vs[(tb + 3) * 128 + dv]}; }
    }
#pragma unroll
    for (int q = 0; q < 2; ++q) { const int chunk = tid + 512 * q, fl = chunk & 63, s = (chunk >> 6) & 7, mt = chunk >> 9, tok = 32 * mt + (fl & 31), hh = fl >> 5;
        const f32x4 p0 = *(const LAS f32x4*)(Wf + tok * WF_LD + 16 * s + 4 * hh), p1 = *(const LAS f32x4*)(Wf + tok * WF_LD + 16 * s + 8 + 4 * hh);
        ((v4u*)(gbase + G_WN))[chunk] = (v4u){pk2(-p0.x, -p0.y), pk2(-p0.z, -p0.w), pk2(-p1.x, -p1.y), pk2(-p1.z, -p1.w)}; }
    __syncthreads();
}

template <bool FINAL>
DI void s5_item(const Args& a, LAS unsigned char* Hs8, int pi, int g, int lane) {
    unsigned char* ws = a.ws;
    const int n = lane & 31, hh = lane >> 5;
    const int cx = 2 * pi, cy = 2 * pi + 1, myc = hh ? cy : cx;
    const int half_r = (n >> 2) & 1, idx_r = (n & 3) + 4 * (n >> 3);
    const int arow0 = 64 * (half_r ? cy : cx) + idx_r;
    const bf16* PU = (const bf16*)(ws + WS_PU);
    const bf16x8* BF = (const bf16x8*)(ws + WS_MISC + MISC_BF) + (size_t)(g * 4) * 64 + lane;
    bf16x8 bfr[4];
#pragma unroll
    for (int tt = 0; tt < 4; ++tt) bfr[tt] = BF[tt * 64];
    const f32x4* AB = (const f32x4*)(ws + WS_MISC + MISC_S5AB) + g * 64;
    const f32x4 ab0 = AB[n], ab1 = AB[n + 32];
    float h0r = 0.f, h0i = 0.f, h1r = 0.f, h1i = 0.f;
    const f32x2* E = (const f32x2*)(ws + WS_E);
    bf16x8 cfr[4]; float dsk = 0.f;
    LAS bf16* Hs = (LAS bf16*)Hs8;
    if (FINAL) {
        const bf16x8* CF = (const bf16x8*)(ws + WS_MISC + MISC_CF) + (size_t)(g * 4) * 64 + lane;
#pragma unroll
        for (int s = 0; s < 4; ++s) cfr[s] = CF[s * 64];
        dsk = a.in[I_S5D][16 * g + (lane & 15)];
        if (cx >= 256) {
            const int b = myc - 256;
            h0r = a.in[I_S5RE][(size_t)(b * 32 + g) * 64 + n]; h0i = a.in[I_S5IM][(size_t)(b * 32 + g) * 64 + n];
            h1r = a.in[I_S5RE][(size_t)(b * 32 + g) * 64 + n + 32]; h1i = a.in[I_S5IM][(size_t)(b * 32 + g) * 64 + n + 32];
        } else {
            const int cf = cx & ~63;
#pragma unroll 4
            for (int cp = cf; cp < cy; ++cp) {
                const f32x2 e0 = E[(size_t)(cp * 32 + g) * 64 + n], e1 = E[(size_t)(cp * 32 + g) * 64 + n + 32];
                const float n0r = ab0.z * h0r - ab0.w * h0i + e0.x, n0i = ab0.z * h0i + ab0.w * h0r + e0.y;
                const float n1r = ab1.z * h1r - ab1.w * h1i + e1.x, n1i = ab1.z * h1i + ab1.w * h1r + e1.y;
                const bool act = cp < myc;
                h0r = act ? n0r : h0r; h0i = act ? n0i : h0i; h1r = act ? n1r : h1r; h1i = act ? n1i : h1i;
            }
        }
    }
    const f32x16 zero = {0.f, 0.f, 0.f, 0.f, 0.f, 0.f, 0.f, 0.f, 0.f, 0.f, 0.f, 0.f, 0.f, 0.f, 0.f, 0.f};
    for (int sb = 0; sb < 4; ++sb) {
        const bf16x8 ua = *(const bf16x8*)(PU + (size_t)(arow0 + 16 * sb) * 512 + 16 * g + 8 * hh);
        f32x16 X0 = MFMA32(ua, bfr[0], zero), X1 = MFMA32(ua, bfr[1], zero), X2 = MFMA32(ua, bfr[2], zero), X3 = MFMA32(ua, bfr[3], zero);
#pragma unroll
        for (int idx = 0; idx < 16; ++idx) {
            const float t0r = ab0.x * h0r - ab0.y * h0i + X0[idx], t0i = ab0.x * h0i + ab0.y * h0r + X2[idx];
            const float t1r = ab1.x * h1r - ab1.y * h1i + X1[idx], t1i = ab1.x * h1i + ab1.y * h1r + X3[idx];
            h0r = t0r; h0i = t0i; h1r = t1r; h1i = t1i;
            if (FINAL) { v2u o; o.x = pk2(h0r, h0i); o.y = pk2(h1r, h1i); *(LAS v2u*)(Hs + (16 * hh + idx) * 136 + 4 * n) = o; }
        }
        if (FINAL) {
            LDS_WAIT();
            const int r16 = lane & 15, kq = lane >> 4;
#pragma unroll
            for (int mi = 0; mi < 2; ++mi) {
                f32x4 y = (f32x4){0.f, 0.f, 0.f, 0.f};
#pragma unroll
                for (int s = 0; s < 4; ++s) { const bf16x8 av = *(const LAS bf16x8*)(Hs + (16 * mi + r16) * 136 + 32 * s + 8 * kq); y = MFMA16(av, cfr[s], y); }
                const int tokb = 64 * (mi ? cy : cx) + 16 * sb + 4 * kq;
#pragma unroll
                for (int reg = 0; reg < 4; ++reg) { const size_t off = (size_t)(tokb + reg) * 512 + 16 * g + r16;
                    const float yy = y[reg] + dsk * bf2f(PU[off]);
                    const float inner = 1.5957691216057308f * (yy + 0.044715f * yy * yy * yy);
                    ((bf16*)(ws + WS_YA))[off] = f2bf(yy / (1.0f + __expf(-inner))); }
            }
            LDS_WAIT();
        }
    }
    if (!FINAL) {
        f32x2* Ew = (f32x2*)(ws + WS_E);
        Ew[(size_t)(myc * 32 + g) * 64 + n] = (f32x2){h0r, h0i}; Ew[(size_t)(myc * 32 + g) * 64 + n + 32] = (f32x2){h1r, h1i};
    } else {
        const bool lastc = myc >= 256 || (myc & 63) == 63;
        if (lastc) {
            const size_t ore = myc >= 256 ? O_S5RE_S + (size_t)((myc - 256) * 32 + g) * 64 : O_S5RE_P + (size_t)((myc >> 6) * 32 + g) * 64;
            const size_t oim = myc >= 256 ? O_S5IM_S + (size_t)((myc - 256) * 32 + g) * 64 : O_S5IM_P + (size_t)((myc >> 6) * 32 + g) * 64;
            a.out[ore + n] = h0r; a.out[ore + n + 32] = h1r; a.out[oim + n] = h0i; a.out[oim + n + 32] = h1i;
        }
    }
}

constexpr int CH_SLOT = 57344;
DI void chain_stage(const unsigned char* ws, LAS unsigned char* L, int item, int slot, int lw, int lane) {
    asm volatile("" : "+v"(lane));
    const unsigned char* src = ws + WS_GDN + (size_t)item * GDN_ITEM + G_WN + lane * 16;
#pragma unroll
    for (int i = 0; i < 14; ++i) { const int chunk = lw * 14 + i;
        __builtin_amdgcn_global_load_lds((const unsigned*)(src + chunk * 1024), (LAS unsigned*)(L + slot * CH_SLOT + chunk * 1024), 16, 0, 0); }
}
#define CH_BARRIER() do { asm volatile("s_waitcnt lgkmcnt(0)" ::: "memory"); __builtin_amdgcn_s_barrier(); asm volatile("" ::: "memory"); } while (0)
DI void gdn_chain_wg(const Args& a, LAS unsigned char* L, int seq, int h, int wave, int lane) {
    unsigned char* ws = a.ws;
    const int nch = seq < 4 ? 64 : 1, c0 = seq < 4 ? seq * 64 : 256 + (seq - 4);
    if (wave >= 4) {
        chain_stage(ws, L, c0 * 4 + h, 0, wave - 4, lane); VM_WAIT();
        CH_BARRIER();
        for (int ci = 0; ci < nch; ++ci) {
            if (ci + 1 < nch) chain_stage(ws, L, (c0 + ci + 1) * 4 + h, (ci & 1) ^ 1, wave - 4, lane);
            VM_WAIT();
            CH_BARRIER();
        }
        return;
    }
    const int r = lane & 31, hh = lane >> 5, sl = wave;
    const float* GL = (const float*)(ws + WS_MISC + MISC_GL);
    const __amdgpu_buffer_rsrc_t rsO = __builtin_amdgcn_make_buffer_rsrc((void*)(ws + WS_OBUF), 0, (unsigned)((size_t)T * 512 * 4), 0x00020000);
    f32x16 S[4], vn[2]; float gln;
    if (seq >= 4) {
        const __amdgpu_buffer_rsrc_t rs0 = __builtin_amdgcn_make_buffer_rsrc((void*)(a.in[I_SGDN] + (size_t)((seq - 4) * 4 + h) * 16384), 0, 16384 * 4, 0x00020000);
#pragma unroll
        for (int mtk = 0; mtk < 4; ++mtk)
#pragma unroll
            for (int reg = 0; reg < 16; ++reg) S[mtk][reg] = __builtin_bit_cast(float, __builtin_amdgcn_raw_buffer_load_b32(rs0, (4 * hh * 128 + r) * 4, ((32 * mtk + (reg & 3) + 8 * (reg >> 2)) * 128 + 32 * sl) * 4, 0));
    } else {
#pragma unroll
        for (int mtk = 0; mtk < 4; ++mtk)
#pragma unroll
            for (int reg = 0; reg < 16; ++reg) S[mtk][reg] = 0.f;
    }
    {
        const f32x4* U4 = (const f32x4*)(ws + WS_GDN + (size_t)(c0 * 4 + h) * GDN_ITEM + G_U);
#pragma unroll
        for (int mt = 0; mt < 2; ++mt)
#pragma unroll
            for (int q = 0; q < 4; ++q) { const f32x4 u = U4[(((sl * 2 + mt) * 4 + q) * 2 + hh) * 32 + r]; vn[mt][4 * q] = u.x; vn[mt][4 * q + 1] = u.y; vn[mt][4 * q + 2] = u.z; vn[mt][4 * q + 3] = u.w; }
        gln = GL[c0 * 4 + h];
    }
    CH_BARRIER();
    for (int ci = 0; ci < nch; ++ci) {
        const int item = (c0 + ci) * 4 + h, slot = ci & 1;
        const LAS bf16x8* F = (const LAS bf16x8*)(L + slot * CH_SLOT) + lane;
        f32x16 o[2];
        const float gl = gln;
        if (ci + 1 < nch) gln = GL[item + 4];
#pragma unroll
        for (int reg = 0; reg < 16; ++reg) { o[0][reg] = 0.f; o[1][reg] = 0.f; }
#pragma unroll
        for (int s = 0; s < 8; ++s) {
            const bf16x8 Sb = pack8(S[s >> 1], s & 1);
            vn[0] = MFMA32(F[(0 * 8 + s) * 64], Sb, vn[0]); vn[1] = MFMA32(F[(1 * 8 + s) * 64], Sb, vn[1]);
            o[0] = MFMA32(F[1024 + (0 * 8 + s) * 64], Sb, o[0]); o[1] = MFMA32(F[1024 + (1 * 8 + s) * 64], Sb, o[1]);
        }
        bf16x8 vb[4];
#pragma unroll
        for (int k4 = 0; k4 < 4; ++k4) vb[k4] = pack8(vn[k4 >> 1], k4 & 1);
        if (ci + 1 < nch) {
            const f32x4* U4 = (const f32x4*)(ws + WS_GDN + (size_t)(item + 4) * GDN_ITEM + G_U);
#pragma unroll
            for (int mt = 0; mt < 2; ++mt)
#pragma unroll
                for (int q = 0; q < 4; ++q) { const f32x4 u = U4[(((sl * 2 + mt) * 4 + q) * 2 + hh) * 32 + r]; vn[mt][4 * q] = u.x; vn[mt][4 * q + 1] = u.y; vn[mt][4 * q + 2] = u.z; vn[mt][4 * q + 3] = u.w; }
        }
#pragma unroll
        for (int mt = 0; mt < 2; ++mt)
#pragma unroll
            for (int k4 = 0; k4 < 4; ++k4) o[mt] = MFMA32(F[2048 + (mt * 4 + k4) * 64], vb[k4], o[mt]);
#pragma unroll
        for (int mtk = 0; mtk < 4; ++mtk) {
            S[mtk] = S[mtk] * gl;
#pragma unroll
            for (int k4 = 0; k4 < 4; ++k4) S[mtk] = MFMA32(F[2560 + (mtk * 4 + k4) * 64], vb[k4], S[mtk]);
        }
#pragma unroll
        for (int mt = 0; mt < 2; ++mt)
#pragma unroll
            for (int reg = 0; reg < 16; ++reg) { const float ov = o[mt][reg];
                __builtin_amdgcn_raw_buffer_store_b32(__float_as_uint(ov), rsO, (4 * hh * 512 + r) * 4, (((c0 + ci) * 64 + 32 * mt + (reg & 3) + 8 * (reg >> 2)) * 512 + h * 128 + 32 * sl) * 4, 0); }
        CH_BARRIER();
    }
    const __amdgpu_buffer_rsrc_t rsS = __builtin_amdgcn_make_buffer_rsrc((void*)(a.out + (seq < 4 ? O_GDN_P + (size_t)(seq * 4 + h) * 16384 : O_GDN_S + (size_t)((seq - 4) * 4 + h) * 16384)), 0, 16384 * 4, 0x00020000);
#pragma unroll
    for (int mtk = 0; mtk < 4; ++mtk)
#pragma unroll
        for (int reg = 0; reg < 16; ++reg) { const float sv = S[mtk][reg];
            __builtin_amdgcn_raw_buffer_store_b32(__float_as_uint(sv), rsS, (4 * hh * 128 + r) * 4, ((32 * mtk + (reg & 3) + 8 * (reg >> 2)) * 128 + 32 * sl) * 4, 0); }
}

DI void gdn_norm_rows(const Args& a, int lane, int w0, int nw) {
    unsigned char* ws = a.ws;
    const int hd = lane >> 4, dv0 = (lane & 15) * 8, col = hd * 128 + dv0;
    const f32x4 g0 = *(const f32x4*)(a.in[I_NORMG] + dv0), g1 = *(const f32x4*)(a.in[I_NORMG] + dv0 + 4);
    for (int row = w0; row < T; row += nw) {
        const float* op = (const float*)(ws + WS_OBUF) + (size_t)row * 512 + col;
        const f32x4 o0 = *(const f32x4*)op, o1 = *(const f32x4*)(op + 4);
        float ss = (o0.x * o0.x + o0.y * o0.y) + (o0.z * o0.z + o0.w * o0.w) + (o1.x * o1.x + o1.y * o1.y) + (o1.z * o1.z + o1.w * o1.w);
        ss += __shfl_xor(ss, 1); ss += __shfl_xor(ss, 2); ss += __shfl_xor(ss, 4); ss += __shfl_xor(ss, 8);
        const float rs = 1.0f / sqrtf(ss * (1.0f / 128.0f) + RMS_EPS);
        const bf16x8 z = *(const bf16x8*)((const bf16*)(ws + WS_PZ) + (size_t)row * 512 + col);
        float zz[8], y[8];
#pragma unroll
        for (int e = 0; e < 8; ++e) { const float zv = bf2f((unsigned short)z[e]); zz[e] = zv / (1.0f + __expf(-zv)); }
        y[0] = o0.x * rs * g0.x * zz[0]; y[1] = o0.y * rs * g0.y * zz[1]; y[2] = o0.z * rs * g0.z * zz[2]; y[3] = o0.w * rs * g0.w * zz[3];
        y[4] = o1.x * rs * g1.x * zz[4]; y[5] = o1.y * rs * g1.y * zz[5]; y[6] = o1.z * rs * g1.z * zz[6]; y[7] = o1.w * rs * g1.w * zz[7];
        v4u o; o.x = pk2(y[0], y[1]); o.y = pk2(y[2], y[3]); o.z = pk2(y[4], y[5]); o.w = pk2(y[6], y[7]);
        *(v4u*)((bf16*)(ws + WS_MIX) + (size_t)row * 1024 + 512 + col) = o;
    }
}

DI void phase7(const Args& a, int lane, int gw, int NGW) {
    unsigned char* ws = a.ws;
    const float* mod = (const float*)(ws + WS_MOD);
    f32x4 lg[4], lb[4];
#pragma unroll
    for (int j = 0; j < 4; ++j) { lg[j] = *(const f32x4*)(a.in[I_LN1G] + 4 * lane + 256 * j); lb[j] = *(const f32x4*)(a.in[I_LN1B] + 4 * lane + 256 * j); }
    for (int row = gw; row < T; row += NGW) {
        const float* xr = a.out + O_Y + (size_t)row * D;
        const float* md = mod + seq_of_row(row) * 6144;
        f32x4 v[4]; float s = 0.f;
#pragma unroll
        for (int j = 0; j < 4; ++j) { v[j] = *(const f32x4*)(xr + 4 * lane + 256 * j); s += (v[j].x + v[j].y) + (v[j].z + v[j].w); }
        float mean = wave_sum(s) * (1.f / D), s2 = 0.f;
#pragma unroll
        for (int j = 0; j < 4; ++j) { v[j] = v[j] - mean; s2 += (v[j].x * v[j].x + v[j].y * v[j].y) + (v[j].z * v[j].z + v[j].w * v[j].w); }
        float rstd = 1.f / sqrtf(wave_sum(s2) * (1.f / D) + LN_EPS);
        float* x1 = (float*)(ws + WS_X1) + (size_t)row * D; s = 0.f;
#pragma unroll
        for (int j = 0; j < 4; ++j) { v[j] = v[j] * rstd * lg[j] + lb[j]; *(f32x4*)(x1 + 4 * lane + 256 * j) = v[j]; s += (v[j].x + v[j].y) + (v[j].z + v[j].w); }
        mean = wave_sum(s) * (1.f / D); s2 = 0.f;
#pragma unroll
        for (int j = 0; j < 4; ++j) { v[j] = v[j] - mean; s2 += (v[j].x * v[j].x + v[j].y * v[j].y) + (v[j].z * v[j].z + v[j].w * v[j].w); }
        rstd = 1.f / sqrtf(wave_sum(s2) * (1.f / D) + LN_EPS);
        bf16* orow = (bf16*)(ws + WS_XN) + (size_t)row * D;
#pragma unroll
        for (int j = 0; j < 4; ++j) { const int col = 4 * lane + 256 * j; const f32x4 sh = *(const f32x4*)(md + 3072 + col), sc = *(const f32x4*)(md + 4096 + col);
            const f32x4 hv = v[j] * rstd * (sc + 1.0f) + sh;
            v2u o; o.x = pk2(hv.x, hv.y); o.y = pk2(hv.z, hv.w); *(v2u*)(orow + col) = o; }
    }
}
DI void phase10(const Args& a, int lane, int gw, int NGW) {
    f32x4 lg[4], lb[4];
#pragma unroll
    for (int j = 0; j < 4; ++j) { lg[j] = *(const f32x4*)(a.in[I_LN2G] + 4 * lane + 256 * j); lb[j] = *(const f32x4*)(a.in[I_LN2B] + 4 * lane + 256 * j); }
    for (int row = gw; row < T; row += NGW) {
        float* xr = a.out + O_Y + (size_t)row * D;
        f32x4 v[4]; float s = 0.f;
#pragma unroll
        for (int j = 0; j < 4; ++j) { v[j] = *(const f32x4*)(xr + 4 * lane + 256 * j); s += (v[j].x + v[j].y) + (v[j].z + v[j].w); }
        const float mean = wave_sum(s) * (1.f / D); float s2 = 0.f;
#pragma unroll
        for (int j = 0; j < 4; ++j) { v[j] = v[j] - mean; s2 += (v[j].x * v[j].x + v[j].y * v[j].y) + (v[j].z * v[j].z + v[j].w * v[j].w); }
        const float rstd = 1.f / sqrtf(wave_sum(s2) * (1.f / D) + LN_EPS);
#pragma unroll
        for (int j = 0; j < 4; ++j) *(f32x4*)(xr + 4 * lane + 256 * j) = v[j] * rstd * lg[j] + lb[j];
    }
}
#define XB_TMO      128
#define XB_XCNT(j)  (256  + 64 * (j))
#define XB_XSUB(j)  (1280 + 64 * (j))
#define XB_XGEN(j)  (2304 + 64 * (j))
#define XB_TOP      3328
#define XB_TOPGEN   3392
#define XCD_BAR_WORDS 3456
#define XB_SPIN_CAP (1u << 18)

__device__ __forceinline__ unsigned xb_ld(unsigned* p)              { return __hip_atomic_load(p, __ATOMIC_RELAXED, __HIP_MEMORY_SCOPE_AGENT); }
__device__ __forceinline__ unsigned xb_add(unsigned* p, unsigned v) { return __hip_atomic_fetch_add(p, v, __ATOMIC_RELAXED, __HIP_MEMORY_SCOPE_AGENT); }
__device__ __forceinline__ unsigned xb_xcc_id() { return (unsigned)__builtin_amdgcn_s_getreg((3 << 11) | 20) & 0xFu; }
#define XB_SPIN(cond, bar) do { unsigned _sp = 0; while (cond) { __builtin_amdgcn_s_sleep(1); \
    if ((++_sp & 255u) == 0u) { if (xb_ld(&(bar)[XB_TMO])) break; if (_sp > XB_SPIN_CAP) { atomicAdd(&(bar)[XB_TMO], 1u); break; } } } } while (0)

struct XcdBarrier {
    unsigned* bar; unsigned x;
    volatile LAS unsigned* st;
};

__device__ __forceinline__ XcdBarrier xcd_barrier_post(unsigned* bar, volatile LAS unsigned* st) {
    XcdBarrier b; b.bar = bar; b.x = xb_xcc_id(); b.st = st;
    if (threadIdx.x == 0) (void)xb_add(&bar[XB_XCNT(b.x)], 1u);
    return b;
}
__device__ __forceinline__ void xcd_barrier_complete(unsigned* bar, unsigned x, unsigned& nloc, unsigned& nx) {
    const unsigned G = gridDim.x * gridDim.y * gridDim.z;
    unsigned sum, cnt, mine, sp = 0u;
    for (;;) {
        sum = 0u; cnt = 0u; mine = 0u;
#pragma unroll
        for (unsigned j = 0; j < 16; ++j) { const unsigned c = xb_ld(&bar[XB_XCNT(j)]); sum += c; cnt += (c > 0u) ? 1u : 0u; mine = (j == x) ? c : mine; }
        if (sum == G) break;
        __builtin_amdgcn_s_sleep(1);
        if ((++sp & 255u) == 0u) { if (xb_ld(&bar[XB_TMO])) break; if (sp > XB_SPIN_CAP) { atomicAdd(&bar[XB_TMO], 1u); break; } }
    }
    nloc = mine > 0u ? mine : 1u; nx = cnt > 0u ? cnt : 1u;
}

__device__ __forceinline__ void xcd_barrier(const XcdBarrier& b) {
    asm volatile("s_waitcnt vmcnt(0)" ::: "memory");
    __syncthreads();
    if (threadIdx.x == 0) {
        unsigned* bar = b.bar;
        __builtin_amdgcn_s_waitcnt(0);
        unsigned nloc = b.st[0], nx = b.st[1];
        if (nloc == 0u) { xcd_barrier_complete(bar, b.x, nloc, nx); b.st[0] = nloc; b.st[1] = nx; }
        const unsigned old = xb_add(&bar[XB_XSUB(b.x)], 1u);
        const unsigned gen = old / nloc;
        if (old + 1u == (gen + 1u) * nloc) {
            __builtin_amdgcn_fence(__ATOMIC_RELEASE, "agent");
            asm volatile("s_waitcnt vmcnt(0)" ::: "memory");
            const unsigned og = xb_add(&bar[XB_TOP], 1u);
            const unsigned tg = og / nx;
            if (og + 1u == (tg + 1u) * nx) xb_add(&bar[XB_TOPGEN], 1u);
            else XB_SPIN(xb_ld(&bar[XB_TOPGEN]) == tg, bar);
            __builtin_amdgcn_fence(__ATOMIC_ACQUIRE, "agent");
            xb_add(&bar[XB_XGEN(b.x)], 1u);
            asm volatile("s_waitcnt vmcnt(0)" ::: "memory");
        } else {
            XB_SPIN(xb_ld(&bar[XB_XGEN(b.x)]) == gen, bar);
            __builtin_amdgcn_fence(__ATOMIC_ACQUIRE, "agent");
            asm volatile("s_waitcnt vmcnt(0)" ::: "memory");
        }
    }
    __syncthreads();
}

#ifndef MK_N_LAUNCHES
#define MK_N_LAUNCHES 1
#endif
constexpr int N_PHASES = 11;
constexpr int N_CHAIN = 48;

__global__ void __launch_bounds__(NWAVES * 64, 2) fwd_kernel(Args args) {
    extern __shared__ __attribute__((aligned(16))) unsigned char lds[];
    LAS unsigned char* L = (LAS unsigned char*)lds;
    const int tid = threadIdx.x, lane = tid & 63, wave = __builtin_amdgcn_readfirstlane(tid >> 6);
    const int G = gridDim.x, bx = blockIdx.x;
    const int vcu = (G % 8 == 0) ? (bx % 8) * (G / 8) + bx / 8 : bx;
    const int gw = vcu * NWAVES + wave, NGW = G * NWAVES;
    unsigned char* ws = args.ws;
    for (int u = tid; u < (LDS_BYTES - LDSCTL_OFF) / 4; u += NWAVES * 64) ((LAS unsigned*)(L + LDSCTL_OFF))[u] = 0u;
    __syncthreads();
    XcdBarrier bar = xcd_barrier_post((unsigned*)(ws + WS_CTL) + CW_BAR, (volatile LAS unsigned*)(L + MISC_OFF) + 8);
    const int lo = args.ph_lo, hi = args.ph_hi;
#ifndef PHASE_MASK
#define PHASE_MASK 0x7ff
#endif
#define IN(k) (((PHASE_MASK >> (k)) & 1) && lo <= (k) && (k) < hi)
#define SEAM(k) do { if (IN(k) && IN((k) + 1)) xcd_barrier(bar); } while (0)

    if (IN(0)) { phase0(args, L, tid, lane, wave, gw, NGW); SEAM(0); }
    if (IN(1)) { phase1(args, L, tid, lane, gw, NGW); SEAM(1); }
    if (IN(2)) {
        pg8::Gemm g{(const bf16*)(ws + WS_XN), (const bf16*)(ws + WS_WIN), T, NIN, D}; pg8::StaticOrder S; S.init(T, NIN, G, bx);
        pg8::EpiBf16Split E{(bf16*)(ws + WS_PU), 512, 512, (size_t)T * 512};
        pg8::gemm_phase<pg8::EpiBf16Split, pg8::StaticOrder, true, true>(L, g, S, E);
        SEAM(2);
    }
#ifndef DUP_MASK
#define DUP_MASK 0
#endif
#define P3_BODY do { \
        for (int item = bx; item < NITEM; item += G) gdn_prep_item(args, L, item, tid, lane, wave); \
        for (int it = gw; it < (NCHUNK / 2) * 32; it += NGW) s5_item<false>(args, L, it >> 5, it & 31, lane); } while (0)
    if (IN(3)) {
        P3_BODY;
        if (DUP_MASK & 8) { xcd_barrier(bar); P3_BODY; }
        SEAM(3);
    }
#define P4_BODY do { \
        const int nchw = N_CHAIN;     \
        if (bx < nchw) { \
            { const int k = bx; const int seq = k < 16 ? (k >> 2) : 4 + ((k - 16) >> 2), h = k & 3; gdn_chain_wg(args, L, seq, h, wave, lane); } \
        } else { \
            const int wid = (bx - nchw) * NWAVES + wave, NW = (G - nchw) * NWAVES; \
            for (int it = wid; it < (NCHUNK / 2) * 32; it += NW) s5_item<true>(args, L + wave * 8704, it >> 5, it & 31, lane); \
        } } while (0)
    if (IN(4)) {
        P4_BODY;
        if (DUP_MASK & 16) { xcd_barrier(bar); P4_BODY; }
        SEAM(4);
    }
    if (IN(5)) {
        pg8::Gemm g{(const bf16*)(ws + WS_YA), (const bf16*)(ws + WS_WGLU), T, 1024, 512}; pg8::StaticOrder S; S.init(T, 1024, G, bx);
        pg8::EpiGate<0> E{(bf16*)(ws + WS_MIX), 1024};
        pg8::gemm_phase<pg8::EpiGate<0>, pg8::StaticOrder, true, true>(L, g, S, E);
        gdn_norm_rows(args, lane, gw, NGW);
        SEAM(5);
    }
    if (IN(6)) {
        pg8::Gemm g{(const bf16*)(ws + WS_MIX), (const bf16*)(ws + WS_WOUT), T, D, D}; pg8::StaticOrder S; S.init(T, D, G, bx);
        pg8::EpiRes E{args.in[I_XP], args.in[I_XS], (const float*)(ws + WS_MOD) + 2048, args.out + O_Y, ALPHA};
        pg8::gemm_phase<pg8::EpiRes, pg8::StaticOrder, true, true>(L, g, S, E);
        SEAM(6);
    }
    if (IN(7)) { phase7(args, lane, gw, NGW); SEAM(7); }
    if (IN(8)) {
        pg8::Gemm g{(const bf16*)(ws + WS_XN), (const bf16*)(ws + WS_WUP), T, 2 * DFF, D}; pg8::StaticOrder S; S.init(T, 2 * DFF, G, bx);
        pg8::EpiGate<1> E{(bf16*)(ws + WS_HID), DFF};
        pg8::gemm_phase<pg8::EpiGate<1>, pg8::StaticOrder, true, true>(L, g, S, E);
        SEAM(8);
    }
    if (IN(9)) {
        pg8::Gemm g{(const bf16*)(ws + WS_HID), (const bf16*)(ws + WS_WDOWN), T, D, DFF}; pg8::StaticOrder S; S.init(T, D, G, bx);
        pg8::EpiRes E{(const float*)(ws + WS_X1), (const float*)(ws + WS_X1) + (size_t)TP * D, (const float*)(ws + WS_MOD) + 5120, args.out + O_Y, ALPHA};
        pg8::gemm_phase<pg8::EpiRes, pg8::StaticOrder, true, true>(L, g, S, E);
        SEAM(9);
    }
    if (IN(10)) { phase10(args, lane, gw, NGW); }
#undef IN
#undef SEAM
}

extern "C" void kernel_launch(void* const* d_in, const int* in_sizes, int n_in, void* d_out, int out_size, void* d_ws, size_t ws_size, hipStream_t stream) {
    static int grid = 0;
    if (grid == 0) {
        if (n_in != N_IN || out_size != (int)O_END || ws_size < WS_END) { fprintf(stderr, "kernel_launch: unexpected shapes (n_in %d, out %d, ws %zu); nothing launched\n", n_in, out_size, ws_size); grid = -1; return; }
        int dev = 0, cus = 0, per_cu = 0;
        if (hipGetDevice(&dev) != hipSuccess || hipDeviceGetAttribute(&cus, hipDeviceAttributeMultiprocessorCount, dev) != hipSuccess) { grid = -1; return; }
        if (hipFuncSetAttribute((const void*)fwd_kernel, hipFuncAttributeMaxDynamicSharedMemorySize, LDS_BYTES) != hipSuccess) { fprintf(stderr, "kernel_launch: hipFuncSetAttribute failed\n"); grid = -1; return; }
        if (hipOccupancyMaxActiveBlocksPerMultiprocessor(&per_cu, (const void*)fwd_kernel, NWAVES * 64, LDS_BYTES) != hipSuccess || per_cu < 1) { fprintf(stderr, "kernel_launch: occupancy query says %d blocks per CU\n", per_cu); per_cu = 1; }
        (void)hipGetLastError();
        grid = cus;
        if (grid <= N_CHAIN) { fprintf(stderr, "kernel_launch: needs more than %d CUs\n", N_CHAIN); grid = -1; return; }
    }
    if (grid < 0) return;
    (void)hipMemsetAsync((char*)d_ws + WS_CTL, 0, CTL_ZERO_BYTES, stream);
    Args a{};
    for (int i = 0; i < N_IN; ++i) a.in[i] = (const float*)d_in[i];
    a.out = (float*)d_out; a.ws = (unsigned char*)d_ws;
#if MK_N_LAUNCHES == 1
    a.ph_lo = 0; a.ph_hi = N_PHASES;
    hipLaunchKernelGGL(fwd_kernel, dim3(grid), dim3(NWAVES * 64), LDS_BYTES, stream, a);
#else
    for (int p = 0; p < N_PHASES; ++p) { a.ph_lo = p; a.ph_hi = p + 1; hipLaunchKernelGGL(fwd_kernel, dim3(grid), dim3(NWAVES * 64), LDS_BYTES, stream, a); }
#endif
}
```

```cpp
#include <hip/hip_runtime.h>
#include <cstdio>
#include <cstdint>
#include <cmath>
namespace pg8 {
#define PG8_LAS __attribute__((address_space(3)))
typedef unsigned short bf16_t;
typedef short bf16x8 __attribute__((ext_vector_type(8)));
typedef float f32x4 __attribute__((ext_vector_type(4)));
typedef unsigned u32x4 __attribute__((ext_vector_type(4)));
constexpr int BM = 256, BK = 64, HALF = 128, HTB = HALF * BK * 2  , STAGE_BYTES = 8 * HTB, NXCD = 8, WGM = 8;

__host__ __device__ __forceinline__ int lds_byte(int r, int c) { const int st = (r >> 4) * 2 + (c >> 5), rr = r & 15, cc = c & 31, ob = rr * 64 + cc * 2; return st * 1024 + (ob ^ (((ob >> 9) & 1) << 5)); }
__host__ __device__ __forceinline__ void stage_rc(int b, int& R, int& C) { const int st = b / 1024, sb = b % 1024, swz = sb ^ (((sb >> 9) & 1) << 5); R = (st >> 1) * 16 + swz / 64; C = (st & 1) * 32 + (swz % 64) / 2; }
__host__ __device__ __forceinline__ int perm32(int rho) { const int n = rho >> 4, i = rho & 15; return 8 * (i >> 2) + 4 * n + (i & 3); }

struct Unit { int pm, pn; };
struct Gemm { const bf16_t* A; const bf16_t* Bt; int M, N, K; };

struct StaticOrder {
    int nM, nN, nwg, G, c;
    __host__ __device__ void init(int M, int N, int G_, int c_) { nM = M / BM; nN = N / BM; nwg = nM * nN; G = G_; c = c_; }
    __host__ __device__ bool next(int i, Unit& u) const {
        const long L = (long)i * G + c; if (L >= nwg) return false;
        int wgid = (int)L; { const int q = nwg / NXCD, r = nwg % NXCD, xcd = wgid % NXCD, off = wgid / NXCD; wgid = (xcd < r ? xcd * (q + 1) : r * (q + 1) + (xcd - r) * q) + off; }
        const int nig = WGM * nN, gid = wgid / nig, fm = gid * WGM, gsz = (nM - fm) < WGM ? (nM - fm) : WGM;
        u.pm = fm + ((wgid % nig) % gsz); u.pn = (wgid % nig) / gsz; return true;
    }
    __device__ __forceinline__ void a_ready(const Unit&) const {}
    __device__ __forceinline__ void done(const Unit&) const {}
};

typedef float f32x2 __attribute__((ext_vector_type(2)));
typedef __bf16 bf16x2n __attribute__((ext_vector_type(2)));
__device__ __forceinline__ unsigned cvt_pk_bf16(float lo, float hi) { f32x2 v = {lo, hi}; return __builtin_bit_cast(unsigned, __builtin_convertvector(v, bf16x2n)); }

struct EpiBf16Split {
    static constexpr bool PERM = true, AFTER_DRAIN = false;
    bf16_t* O; int ldc; int split_cols; size_t split_stride;
    __device__ __forceinline__ void operator()(const f32x4 (&acc)[2][2][4][2], const Unit& u, int wr, int wc, int fr, int fq) const {
        const int row0 = u.pm * BM + wr * 64 + fr; int colt = u.pn * BM; bf16_t* base = O;
        if (split_cols) { const int t = colt / split_cols; base += (size_t)t * split_stride; colt -= t * split_cols; }
        const int col0 = colt + wc * 32 + 8 * fq;
#pragma unroll
        for (int ai = 0; ai < 2; ++ai)
#pragma unroll
            for (int m = 0; m < 4; ++m) { bf16_t* rowp = base + (size_t)(row0 + ai * HALF + m * 16) * ldc + col0;
#pragma unroll
                for (int bj = 0; bj < 2; ++bj) { const f32x4 v0 = acc[ai][bj][m][0], v1 = acc[ai][bj][m][1];
                    u32x4 w; w.x = cvt_pk_bf16(v0[0], v0[1]); w.y = cvt_pk_bf16(v0[2], v0[3]); w.z = cvt_pk_bf16(v1[0], v1[1]); w.w = cvt_pk_bf16(v1[2], v1[3]);
                    *(u32x4*)(rowp + bj * HALF) = w; } }
    }
};
template <int MODE> struct EpiGate {
    static constexpr bool PERM = true, AFTER_DRAIN = false;
    bf16_t* O; int ldc;
    __device__ __forceinline__ static float gate1(float a, float b) {
        if (MODE == 0) return a * __builtin_amdgcn_rcpf(1.0f + __expf(-b));
        else return a * __builtin_amdgcn_rcpf(1.0f + __expf(-a)) * b;
    }
    __device__ __forceinline__ void operator()(const f32x4 (&acc)[2][2][4][2], const Unit& u, int wr, int wc, int fr, int fq) const {
        const int row0 = u.pm * BM + wr * 64 + fr; const int col0 = u.pn * HALF + wc * 32 + 8 * fq;
#pragma unroll
        for (int ai = 0; ai < 2; ++ai)
#pragma unroll
            for (int m = 0; m < 4; ++m) { bf16_t* rowp = O + (size_t)(row0 + ai * HALF + m * 16) * ldc + col0;
                const f32x4 a0 = acc[ai][0][m][0], a1 = acc[ai][0][m][1], b0 = acc[ai][1][m][0], b1 = acc[ai][1][m][1];
                u32x4 w; w.x = cvt_pk_bf16(gate1(a0[0], b0[0]), gate1(a0[1], b0[1])); w.y = cvt_pk_bf16(gate1(a0[2], b0[2]), gate1(a0[3], b0[3]));
                w.z = cvt_pk_bf16(gate1(a1[0], b1[0]), gate1(a1[1], b1[1])); w.w = cvt_pk_bf16(gate1(a1[2], b1[2]), gate1(a1[3], b1[3]));
                *(u32x4*)rowp = w; }
    }
};
struct EpiRes {
    static constexpr bool PERM = false, AFTER_DRAIN = false;
    const float* xp; const float* xs; const float* gate; float* out; float alpha;
    __device__ __forceinline__ void operator()(const f32x4 (&acc)[2][2][4][2], const Unit& u, int wr, int wc, int fr, int fq) const {
        const int col0 = u.pn * BM + wc * 32 + 4 * fq;
#pragma unroll
        for (int ai = 0; ai < 2; ++ai) {
            const int seq = u.pm < 64 ? (u.pm >> 4) : 4 + 4 * (u.pm - 64) + 2 * ai + wr;
            const float* gp = gate + (size_t)seq * 6144 + col0;
#pragma unroll
            for (int m = 0; m < 4; ++m) { const int row = u.pm * BM + ai * HALF + wr * 64 + m * 16 + fr;
                const float* xr = (u.pm < 64 ? xp + (size_t)row * 1024 : xs + (size_t)(row - 16384) * 1024) + col0;
                float* orow = out + (size_t)row * 1024 + col0;
#pragma unroll
                for (int bj = 0; bj < 2; ++bj)
#pragma unroll
                    for (int n = 0; n < 2; ++n) { const f32x4 g4 = *(const f32x4*)(gp + bj * HALF + n * 16), x4 = *(const f32x4*)(xr + bj * HALF + n * 16);
                        *(f32x4*)(orow + bj * HALF + n * 16) = x4 * alpha + (g4 + 1.0f) * acc[ai][bj][m][n]; } }
        }
    }
};

template <class Epi, class Sched, bool ALIGN_EPI = false, bool SP2 = false>
__device__ __forceinline__ void gemm_phase(PG8_LAS unsigned char* lds, const Gemm g, const Sched& S, const Epi& E) {
    const int tid = threadIdx.x, wid = __builtin_amdgcn_readfirstlane(tid >> 6), lane = tid & 63, wr = wid >> 2, wc = wid & 3, fr = lane & 15, fq = lane >> 4;
    const int K = g.K, nt = K / BK;
    unsigned voffA[2], voffB[2];
#pragma unroll
    for (int i = 0; i < 2; ++i) { int R, C; stage_rc(tid * 16 + i * 8192, R, C); const int Rb = Epi::PERM ? ((R & ~31) + perm32(R & 31)) : R;
        voffA[i] = (unsigned)(R * K + C) * 2u; voffB[i] = (unsigned)(Rb * K + C) * 2u; }
    const size_t kstep = (size_t)(BK * 2);
    const size_t hstep = (size_t)HALF * K * 2;
    const size_t tstep = 2 * hstep;
    const unsigned ldsw = (unsigned)wid * 1024u;
    const int aoff = lds_byte(wr * 64 + fr, fq * 8), boff = lds_byte(wc * 32 + fr, fq * 8);
#define PG8_SA(b, h) (((b) * 2 + (h)) * HTB)
#define PG8_SB(b, h) ((4 + (b) * 2 + (h)) * HTB)
#define PG8_STAGE(bufoff, gbase, voff) do { _Pragma("unroll") for (int _i = 0; _i < 2; ++_i) \
        __builtin_amdgcn_global_load_lds((const unsigned*)((const char*)(gbase) + (voff)[_i]), (PG8_LAS unsigned*)(lds + (bufoff) + ldsw + _i * 8192), 16, 0, 0); } while (0)
#define PG8_LDA(dst, b, h) do { _Pragma("unroll") for (int m = 0; m < 4; ++m) _Pragma("unroll") for (int k = 0; k < 2; ++k) dst[m][k] = *(const PG8_LAS bf16x8*)(lds + PG8_SA(b, h) + aoff + m * 2048 + k * 1024); } while (0)
#define PG8_LDB(dst, b, h) do { _Pragma("unroll") for (int n = 0; n < 2; ++n) _Pragma("unroll") for (int k = 0; k < 2; ++k) dst[n][k] = *(const PG8_LAS bf16x8*)(lds + PG8_SB(b, h) + boff + n * 2048 + k * 1024); } while (0)
#define PG8_MMA(ai, bj, At, Bt) do { __builtin_amdgcn_s_setprio(1); _Pragma("unroll") for (int m = 0; m < 4; ++m) _Pragma("unroll") for (int n = 0; n < 2; ++n) _Pragma("unroll") for (int k = 0; k < 2; ++k) \
        acc[ai][bj][m][n] = __builtin_amdgcn_mfma_f32_16x16x32_bf16(Bt[n][k], At[m][k], acc[ai][bj][m][n], 0, 0, 0); __builtin_amdgcn_s_setprio(0); } while (0)
#define PG8_WAIT_V(n) asm volatile("s_waitcnt vmcnt(" #n ")" ::: "memory")
#define PG8_WAIT_L(n) asm volatile("s_waitcnt lgkmcnt(" #n ")" ::: "memory")
#define PG8_BAR __builtin_amdgcn_s_barrier()
#define PG8_SCHED __builtin_amdgcn_sched_barrier(0)
    Unit cur, nxt; int ui = 0;
    if (!S.next(0, cur)) return;
    f32x4 acc[2][2][4][2];
#pragma unroll
    for (int a = 0; a < 2; ++a)
#pragma unroll
        for (int b = 0; b < 2; ++b)
#pragma unroll
            for (int m = 0; m < 4; ++m)
#pragma unroll
                for (int n = 0; n < 2; ++n) acc[a][b][m][n] = (f32x4){0.f, 0.f, 0.f, 0.f};
    bf16x8 At[4][2], B0[2][2], B1[2][2];
    const char* cA = (const char*)g.A + (size_t)cur.pm * tstep; const char* cB = (const char*)g.Bt + (size_t)cur.pn * tstep;
    S.a_ready(cur);
    if constexpr (SP2) {
        PG8_STAGE(PG8_SB(0, 0), cB, voffB); PG8_STAGE(PG8_SB(0, 1), cB + hstep, voffB); PG8_STAGE(PG8_SA(0, 0), cA, voffA); PG8_STAGE(PG8_SA(0, 1), cA + hstep, voffA);
        if (wr == 1) PG8_BAR;
        PG8_WAIT_V(2); PG8_BAR;
        PG8_STAGE(PG8_SB(1, 0), cB + kstep, voffB); PG8_STAGE(PG8_SA(1, 0), cA + kstep, voffA); PG8_STAGE(PG8_SB(1, 1), cB + hstep + kstep, voffB);
        PG8_WAIT_V(6); PG8_BAR;
    } else {
        PG8_STAGE(PG8_SB(0, 0), cB, voffB); PG8_STAGE(PG8_SA(0, 0), cA, voffA); PG8_STAGE(PG8_SB(0, 1), cB + hstep, voffB); PG8_STAGE(PG8_SA(0, 1), cA + hstep, voffA);
        if (wr == 1) PG8_BAR;
        PG8_WAIT_V(4); PG8_BAR;
        PG8_STAGE(PG8_SB(1, 0), cB + kstep, voffB); PG8_STAGE(PG8_SA(1, 0), cA + kstep, voffA); PG8_STAGE(PG8_SB(1, 1), cB + hstep + kstep, voffB);
        PG8_WAIT_V(6); PG8_BAR;
    }
    for (;;) {
        const bool has_next = S.next(ui + 1, nxt);
        const char* nA = has_next ? (const char*)g.A + (size_t)nxt.pm * tstep : cA; const char* nB = has_next ? (const char*)g.Bt + (size_t)nxt.pn * tstep : cB;
        for (int t = 0; t < nt; t += 2) {
            const bool last = (t == nt - 2);
            const char* a1 = cA + (size_t)(t + 1) * kstep;
            const char* a2 = last ? nA : cA + (size_t)(t + 2) * kstep; const char* b2 = last ? nB : cB + (size_t)(t + 2) * kstep;
            const char* a3 = a2 + kstep; const char* b3 = b2 + kstep;
            if (last && has_next) S.a_ready(nxt);
            if constexpr (SP2) {
            PG8_LDB(B0, 0, 0); PG8_LDB(B1, 0, 1); PG8_SCHED; PG8_LDA(At, 0, 0); PG8_STAGE(PG8_SA(1, 1), a1 + hstep, voffA);
            PG8_WAIT_V(8); PG8_WAIT_L(0); PG8_BAR; PG8_MMA(0, 0, At, B0); PG8_MMA(0, 1, At, B1); PG8_BAR; PG8_SCHED;
            PG8_LDA(At, 0, 1); PG8_STAGE(PG8_SB(0, 0), b2, voffB); PG8_STAGE(PG8_SB(0, 1), b2 + hstep, voffB); PG8_STAGE(PG8_SA(0, 0), a2, voffA);
            PG8_WAIT_V(8); PG8_WAIT_L(0); PG8_BAR; PG8_MMA(1, 0, At, B0); PG8_MMA(1, 1, At, B1); PG8_BAR; PG8_SCHED;
            PG8_LDB(B0, 1, 0); PG8_LDB(B1, 1, 1); PG8_SCHED; PG8_LDA(At, 1, 0); PG8_STAGE(PG8_SA(0, 1), a2 + hstep, voffA);
            PG8_WAIT_V(8); PG8_WAIT_L(0); PG8_BAR; PG8_MMA(0, 0, At, B0); PG8_MMA(0, 1, At, B1); PG8_BAR; PG8_SCHED;
            PG8_LDA(At, 1, 1); PG8_STAGE(PG8_SB(1, 0), b3, voffB); PG8_STAGE(PG8_SB(1, 1), b3 + hstep, voffB); PG8_STAGE(PG8_SA(1, 0), a3, voffA);
            PG8_WAIT_V(8); PG8_WAIT_L(0); PG8_BAR; PG8_MMA(1, 0, At, B0); PG8_MMA(1, 1, At, B1); PG8_BAR; PG8_SCHED;
            } else {
            PG8_LDB(B0, 0, 0); PG8_SCHED; PG8_LDA(At, 0, 0); PG8_STAGE(PG8_SA(1, 1), a1 + hstep, voffA);
            PG8_WAIT_L(8); PG8_BAR; PG8_WAIT_L(0); PG8_MMA(0, 0, At, B0); PG8_BAR; PG8_SCHED;
            PG8_LDB(B1, 0, 1); PG8_STAGE(PG8_SB(0, 0), b2, voffB);
            PG8_BAR; PG8_WAIT_L(0); PG8_MMA(0, 1, At, B1); PG8_BAR;
            PG8_LDA(At, 0, 1); PG8_STAGE(PG8_SA(0, 0), a2, voffA);
            PG8_BAR; PG8_WAIT_L(0); PG8_MMA(1, 0, At, B0); PG8_BAR; PG8_SCHED;
            PG8_STAGE(PG8_SB(0, 1), b2 + hstep, voffB);
            PG8_WAIT_V(6); PG8_BAR; PG8_MMA(1, 1, At, B1); PG8_BAR;
            PG8_LDB(B0, 1, 0); PG8_SCHED; PG8_LDA(At, 1, 0); PG8_STAGE(PG8_SA(0, 1), a2 + hstep, voffA);
            PG8_WAIT_L(8); PG8_BAR; PG8_WAIT_L(0); PG8_MMA(0, 0, At, B0); PG8_BAR; PG8_SCHED;
            PG8_LDB(B1, 1, 1); PG8_STAGE(PG8_SB(1, 0), b3, voffB);
            PG8_BAR; PG8_WAIT_L(0); PG8_MMA(0, 1, At, B1); PG8_BAR;
            PG8_LDA(At, 1, 1); PG8_STAGE(PG8_SA(1, 0), a3, voffA);
            PG8_BAR; PG8_WAIT_L(0); PG8_MMA(1, 0, At, B0); PG8_BAR; PG8_SCHED;
            PG8_STAGE(PG8_SB(1, 1), b3 + hstep, voffB);
            PG8_WAIT_V(6); PG8_BAR; PG8_MMA(1, 1, At, B1); PG8_BAR;
            }
        }
        if constexpr (ALIGN_EPI) { if (wr == 0) PG8_BAR; }
        if constexpr (!Epi::AFTER_DRAIN) { E(acc, cur, wr, wc, fr, fq); S.done(cur); }
        if (!has_next) break;
#pragma unroll
        for (int a = 0; a < 2; ++a)
#pragma unroll
            for (int b = 0; b < 2; ++b)
#pragma unroll
                for (int m = 0; m < 4; ++m)
#pragma unroll
                    for (int n = 0; n < 2; ++n) acc[a][b][m][n] = (f32x4){0.f, 0.f, 0.f, 0.f};
        cur = nxt; cA = nA; cB = nB; ++ui;
        if constexpr (ALIGN_EPI) { if (wr == 1) PG8_BAR; }
    }
    PG8_WAIT_V(0);
    if constexpr (!ALIGN_EPI) { if (wr == 0) PG8_BAR; }
    PG8_BAR;
    if constexpr (Epi::AFTER_DRAIN) { E.fused(acc, cur, wr, wc, fr, fq, lds, wid, lane); S.done(cur); }
#undef PG8_SA
#undef PG8_SB
#undef PG8_STAGE
#undef PG8_LDA
#undef PG8_LDB
#undef PG8_MMA
#undef PG8_WAIT_V
#undef PG8_WAIT_L
#undef PG8_BAR
#undef PG8_SCHED
}
}

#define DI __device__ __forceinline__
#define GAS __attribute__((address_space(1)))
#define LAS __attribute__((address_space(3)))
typedef unsigned short bf16;
typedef unsigned v4u __attribute__((ext_vector_type(4)));
typedef unsigned v2u __attribute__((ext_vector_type(2)));
typedef float f32x2 __attribute__((ext_vector_type(2)));
typedef float f32x4 __attribute__((ext_vector_type(4)));
typedef float f32x8 __attribute__((ext_vector_type(8)));
typedef float f32x16 __attribute__((ext_vector_type(16)));
typedef short bf16x8 __attribute__((ext_vector_type(8)));
typedef short bf16x4 __attribute__((ext_vector_type(4)));
typedef __bf16 bf16x8n __attribute__((ext_vector_type(8)));
typedef __bf16 bf16x4n __attribute__((ext_vector_type(4)));
typedef __bf16 bf16x2n __attribute__((ext_vector_type(2)));
typedef GAS unsigned gu32;
#define RLX_AGENT __ATOMIC_RELAXED, __HIP_MEMORY_SCOPE_AGENT
#define LDS_WAIT() asm volatile("s_waitcnt lgkmcnt(0)" ::: "memory")
#define VM_WAIT() asm volatile("s_waitcnt vmcnt(0)" ::: "memory")

constexpr int NWAVES = 8;
constexpr int T = 16896, TP = 16384, D = 1024, DFF = 2816, NIN = 2560, NCHUNK = 264, NITEM = 1056;
constexpr float LN_EPS = 1e-5f, RMS_EPS = 1e-6f, ALPHA = 1.18920711500272f;
enum { I_XP = 0, I_XS, I_S5RE, I_S5IM, I_SGDN, I_CONV, I_CP, I_CS, I_WADA, I_BADA, I_WIN, I_ARE, I_AIM, I_LOGDT, I_BRE, I_BIM, I_CRE, I_CIM, I_S5D, I_WGLU,
       I_CONVW, I_ALOG, I_DTB, I_NORMG, I_WOUT, I_LN1G, I_LN1B, I_WUP, I_WDOWN, I_LN2G, I_LN2B, N_IN };
constexpr size_t O_Y = 0, O_S5RE_P = 17301504, O_S5IM_P = O_S5RE_P + 8192, O_GDN_P = O_S5IM_P + 8192, O_CONV_P = O_GDN_P + 262144,
                 O_S5RE_S = O_CONV_P + 18432, O_S5IM_S = O_S5RE_S + 16384, O_GDN_S = O_S5IM_S + 16384, O_CONV_S = O_GDN_S + 524288, O_END = O_CONV_S + 36864;
static_assert(O_END == 18192384, "output size");
constexpr size_t MiB = 1u << 20, KiB = 1024;
constexpr size_t WS_CTL = 0, CTL_ZERO_BYTES = 1 * MiB;
constexpr int CW_BAR = 4096;
constexpr size_t WS_MOD = 256 * KiB;
constexpr size_t WS_MISC = 1 * MiB;
constexpr size_t MISC_S5AB = 0, MISC_BF = 32 * KiB, MISC_CF = 160 * KiB, MISC_WX = 288 * KiB, MISC_GL = 320 * KiB;
constexpr size_t WS_WIN = 2 * MiB, WS_WGLU = 7 * MiB, WS_WOUT = 8 * MiB, WS_WUP = 10 * MiB, WS_WDOWN = 21 * MiB;
constexpr size_t WS_BA = 27 * MiB, WS_E = 28 * MiB, WS_XN = 34 * MiB;
constexpr size_t PSZ = (size_t)T * 512 * 2;
constexpr size_t WS_PROJ = 67 * MiB, WS_PU = WS_PROJ, WS_PQ = WS_PROJ + PSZ, WS_PK = WS_PROJ + 2 * PSZ, WS_PV = WS_PROJ + 3 * PSZ, WS_PZ = WS_PROJ + 4 * PSZ;
constexpr size_t WS_OBUF = WS_PQ, WS_YA = WS_PV, WS_MIX = WS_XN, WS_X1 = WS_PROJ;
constexpr size_t WS_GDN = 150 * MiB, GDN_ITEM = 90112, WS_HID = WS_GDN;
constexpr size_t G_U = 0, G_WN = 32768, G_QD = 49152, G_QK = 65536, G_KD = 73728;
constexpr size_t WS_END = 241 * MiB;
static_assert(WS_PROJ + 5 * PSZ <= WS_GDN && WS_GDN + NITEM * GDN_ITEM <= WS_END && WS_HID + (size_t)T * DFF * 2 <= WS_END && WS_XN + (size_t)T * D * 2 <= WS_PROJ, "ws map");
static_assert(WS_X1 + (size_t)T * D * 4 <= WS_PZ, "X1 overlay");
constexpr int RING_BYTES = 131072, LDSCTL_OFF = RING_BYTES, MISC_OFF = LDSCTL_OFF + 320, LDS_BYTES = 147456;

DI float bf2f(unsigned short b) { return __uint_as_float((unsigned)b << 16); }
DI unsigned pk2(float lo, float hi) { f32x2 v = {lo, hi}; return __builtin_bit_cast(unsigned, __builtin_convertvector(v, bf16x2n)); }
DI unsigned short f2bf(float x) { return (unsigned short)(pk2(x, 0.f) & 0xffffu); }
DI bf16x8 pack8(const f32x16& x, const int s) {
    f32x8 v;
#pragma unroll
    for (int j = 0; j < 8; ++j) v[j] = x[8 * s + j];
    return __builtin_bit_cast(bf16x8, __builtin_convertvector(v, bf16x8n));
}
DI float row_sum(float v) {
    v += __builtin_bit_cast(float, __builtin_amdgcn_update_dpp(0, __builtin_bit_cast(int, v), 0xB1, 0xf, 0xf, false));
    v += __builtin_bit_cast(float, __builtin_amdgcn_update_dpp(0, __builtin_bit_cast(int, v), 0x4E, 0xf, 0xf, false));
    v += __builtin_bit_cast(float, __builtin_amdgcn_update_dpp(0, __builtin_bit_cast(int, v), 0x141, 0xf, 0xf, false));
    v += __builtin_bit_cast(float, __builtin_amdgcn_update_dpp(0, __builtin_bit_cast(int, v), 0x140, 0xf, 0xf, false));
    return v;
}
DI float wave_sum(float v) {
    v = row_sum(v);
    { const unsigned u = __builtin_bit_cast(unsigned, v); const auto r = __builtin_amdgcn_permlane16_swap(u, u, false, false); v = __builtin_bit_cast(float, (unsigned)r[0]) + __builtin_bit_cast(float, (unsigned)r[1]); }
    { const unsigned u = __builtin_bit_cast(unsigned, v); const auto r = __builtin_amdgcn_permlane32_swap(u, u, false, false); v = __builtin_bit_cast(float, (unsigned)r[0]) + __builtin_bit_cast(float, (unsigned)r[1]); }
    return v;
}
DI int crow(int reg, int h) { return (reg & 3) + 8 * (reg >> 2) + 4 * h; }
#define MFMA32(a, b, c) __builtin_amdgcn_mfma_f32_32x32x16_bf16((a), (b), (c), 0, 0, 0)
#define MFMA16(a, b, c) __builtin_amdgcn_mfma_f32_16x16x32_bf16((a), (b), (c), 0, 0, 0)
#define MFMA4(a, b, c) __builtin_amdgcn_mfma_f32_16x16x4f32((a), (b), (c), 0, 0, 0)

struct Args { const float* in[N_IN]; float* out; unsigned char* ws; int ph_lo, ph_hi; };

DI int seq_of_row(int row) { return row < TP ? (row >> 12) : 4 + ((row - TP) >> 6); }

DI void p0_transpose_item(const float* W, int K, int N, bf16* WT, int n0s, int n0d, int k0, LAS float* scr, int lane) {
#pragma unroll 8
    for (int i = 0; i < 32; ++i) { const int kk = 2 * i + (lane >> 5); scr[kk * 33 + (lane & 31)] = W[(size_t)(k0 + kk) * N + n0s + (lane & 31)]; }
    LDS_WAIT(); asm volatile("" ::: "memory");
    const int c = lane & 7;
#pragma unroll
    for (int j = 0; j < 4; ++j) { const int n = (lane >> 3) + 8 * j; const LAS float* s = scr + (8 * c) * 33 + n;
        v4u o; o.x = pk2(s[0 * 33], s[1 * 33]); o.y = pk2(s[2 * 33], s[3 * 33]); o.z = pk2(s[4 * 33], s[5 * 33]); o.w = pk2(s[6 * 33], s[7 * 33]);
        *(GAS v4u*)(WT + (size_t)(n0d + n) * K + k0 + 8 * c) = o; }
    LDS_WAIT(); asm volatile("" ::: "memory");
}
DI void phase0(const Args& a, LAS unsigned char* L, int tid, int lane, int wave, int gw, int NGW, int skip_ada) {
    unsigned char* ws = a.ws;
    LAS float* scT = (LAS float*)L;
    for (int i = tid; i < 12 * 1024; i += NWAVES * 64) { const int s = i >> 10, k = i & 1023; const float c = s < 4 ? a.in[I_CP][s * 1024 + k] : a.in[I_CS][(s - 4) * 1024 + k];
        scT[k * 12 + s] = c / (1.0f + expf(-c)); }
    __syncthreads();
    LAS float* scr = (LAS float*)(L + 49152 + wave * 8448);
    constexpr int N_ADA = 384, N_S5 = 32, N_WX = 8;
    constexpr int I_WINT = (D / 64) * (NIN / 32), I_GLU = (512 / 64) * (1024 / 32), I_OUT = (D / 64) * (D / 32), I_UP = (D / 64) * (2 * DFF / 32), I_DOWN = (DFF / 64) * (D / 32);
    constexpr int NITEMS = N_ADA + N_S5 + N_WX + I_WINT + I_GLU + I_OUT + I_UP + I_DOWN;
    for (int it0 = gw; it0 < NITEMS; it0 += NGW) {
        int it = it0;
        if (it < N_ADA) {   if (skip_ada) continue;
            const int cb = it >> 4, kc = it & 15;
            f32x4 acc[12];
#pragma unroll
            for (int s = 0; s < 12; ++s) acc[s] = (f32x4){0.f, 0.f, 0.f, 0.f};
            const float* wp = a.in[I_WADA] + (size_t)(kc * 64) * 6144 + cb * 256 + 4 * lane;
#pragma unroll 4
            for (int kk = 0; kk < 64; ++kk) { const f32x4 w = *(const f32x4*)(wp + (size_t)kk * 6144);
                const LAS f32x4* sp = (const LAS f32x4*)(scT + (kc * 64 + kk) * 12); const f32x4 s0 = sp[0], s1 = sp[1], s2 = sp[2];
                acc[0] += w * s0.x; acc[1] += w * s0.y; acc[2] += w * s0.z; acc[3] += w * s0.w; acc[4] += w * s1.x; acc[5] += w * s1.y; acc[6] += w * s1.z; acc[7] += w * s1.w;
                acc[8] += w * s2.x; acc[9] += w * s2.y; acc[10] += w * s2.z; acc[11] += w * s2.w; }
            if (kc == 0) { const f32x4 b = *(const f32x4*)(a.in[I_BADA] + cb * 256 + 4 * lane);
#pragma unroll
                for (int s = 0; s < 12; ++s) acc[s] += b; }
            float* mod = (float*)(ws + WS_MOD) + cb * 256 + 4 * lane;
#pragma unroll
            for (int s = 0; s < 12; ++s)
#pragma unroll
                for (int e = 0; e < 4; ++e) (void)__hip_atomic_fetch_add(mod + s * 6144 + e, acc[s][e], RLX_AGENT);
            continue;
        }
        it -= N_ADA;
        if (it < N_S5) {
            const int g = it, p = lane;
            const float are = a.in[I_ARE][g * 64 + p], aim = a.in[I_AIM][g * 64 + p], dt = expf(a.in[I_LOGDT][g]);
            const float mag = expf(are * dt), ang = aim * dt, abr = mag * cosf(ang), abi = mag * sinf(ang);
            const float mag64 = expf(64.0f * are * dt), ang64 = 64.0f * ang, a64r = mag64 * cosf(ang64), a64i = mag64 * sinf(ang64);
            const float den = are * are + aim * aim, nr = abr - 1.0f, ni = abi;
            const float fr = (nr * are + ni * aim) / den, fi = (ni * are - nr * aim) / den;
            ((f32x4*)(ws + WS_MISC + MISC_S5AB))[g * 64 + p] = (f32x4){abr, abi, a64r, a64i};
            const float* bre = a.in[I_BRE] + (size_t)(g * 64 + p) * 16; const float* bim = a.in[I_BIM] + (size_t)(g * 64 + p) * 16;
            float Br[16], Bi[16];
#pragma unroll
            for (int i = 0; i < 16; ++i) { const float br = bre[i], bi = bim[i]; Br[i] = fr * br - fi * bi; Bi[i] = fr * bi + fi * br; }
            v4u* BF = (v4u*)(ws + WS_MISC + MISC_BF);
            const int n = p & 31, tre = p >> 5, tim = 2 + (p >> 5);
#pragma unroll
            for (int kh = 0; kh < 2; ++kh) {
                v4u o; o.x = pk2(Br[8 * kh + 0], Br[8 * kh + 1]); o.y = pk2(Br[8 * kh + 2], Br[8 * kh + 3]); o.z = pk2(Br[8 * kh + 4], Br[8 * kh + 5]); o.w = pk2(Br[8 * kh + 6], Br[8 * kh + 7]);
                BF[(g * 4 + tre) * 64 + n + 32 * kh] = o;
                o.x = pk2(Bi[8 * kh + 0], Bi[8 * kh + 1]); o.y = pk2(Bi[8 * kh + 2], Bi[8 * kh + 3]); o.z = pk2(Bi[8 * kh + 4], Bi[8 * kh + 5]); o.w = pk2(Bi[8 * kh + 6], Bi[8 * kh + 7]);
                BF[(g * 4 + tim) * 64 + n + 32 * kh] = o; }
            v4u* CF = (v4u*)(ws + WS_MISC + MISC_CF);
            const int j = lane & 15, kq = lane >> 4;
            const float* cre = a.in[I_CRE] + (size_t)(g * 16 + j) * 64; const float* cim = a.in[I_CIM] + (size_t)(g * 16 + j) * 64;
#pragma unroll
            for (int s = 0; s < 4; ++s) { float v[8];
#pragma unroll
                for (int jj = 0; jj < 8; ++jj) { const int kidx = 32 * s + 8 * kq + jj, p32 = kidx >> 2, c4 = kidx & 3, pp = p32 + ((c4 & 2) ? 32 : 0); v[jj] = (c4 & 1) ? -cim[pp] : cre[pp]; }
                v4u o; o.x = pk2(v[0], v[1]); o.y = pk2(v[2], v[3]); o.z = pk2(v[4], v[5]); o.w = pk2(v[6], v[7]);
                CF[(g * 4 + s) * 64 + lane] = o; }
            continue;
        }
        it -= N_S5;
        if (it < N_WX) {
            float* WX = (float*)(ws + WS_MISC + MISC_WX);
            for (int i = 0; i < 16; ++i) { const int k = lane + 64 * i; WX[it * 1024 + k] = a.in[I_WIN][(size_t)k * 2568 + 2560 + it]; }
            continue;
        }
        it -= N_WX;
        if (it < I_WINT) { const int nblk = NIN / 32, kb = it / nblk, nb = it % nblk; p0_transpose_item(a.in[I_WIN], D, 2568, (bf16*)(ws + WS_WIN), 32 * nb, 32 * nb, 64 * kb, scr, lane); continue; }
        it -= I_WINT;
        if (it < I_GLU) { const int nblk = 1024 / 32, kb = it / nblk, nb = it % nblk, nd = 32 * nb, ns = ((nd >> 7) & 1) * 512 + (nd >> 8) * 128 + (nd & 127);
            p0_transpose_item(a.in[I_WGLU], 512, 1024, (bf16*)(ws + WS_WGLU), ns, nd, 64 * kb, scr, lane); continue; }
        it -= I_GLU;
        if (it < I_OUT) { const int nblk = D / 32, kb = it / nblk, nb = it % nblk; p0_transpose_item(a.in[I_WOUT], D, D, (bf16*)(ws + WS_WOUT), 32 * nb, 32 * nb, 64 * kb, scr, lane); continue; }
        it -= I_OUT;
        if (it < I_UP) { const int nblk = 2 * DFF / 32, kb = it / nblk, nb = it % nblk, nd = 32 * nb, ns = ((nd >> 7) & 1) * DFF + (nd >> 8) * 128 + (nd & 127);
            p0_transpose_item(a.in[I_WUP], D, 2 * DFF, (bf16*)(ws + WS_WUP), ns, nd, 64 * kb, scr, lane); continue; }
        it -= I_UP;
        { const int nblk = D / 32, kb = it / nblk, nb = it % nblk; p0_transpose_item(a.in[I_WDOWN], DFF, D, (bf16*)(ws + WS_WDOWN), 32 * nb, 32 * nb, 64 * kb, scr, lane); }
    }
}

DI void phase1(const Args& a, LAS unsigned char* L, int tid, int lane, int gw, int NGW) {
    unsigned char* ws = a.ws;
    LAS float* wx = (LAS float*)L;
    { const float* WXg = (const float*)(ws + WS_MISC + MISC_WX); for (int i = tid; i < 8192; i += NWAVES * 64) wx[i] = WXg[i]; }
    __syncthreads();
    const float* mod = (const float*)(ws + WS_MOD);
    for (int row = gw; row < T; row += NGW) {
        const float* xr = row < TP ? a.in[I_XP] + (size_t)row * D : a.in[I_XS] + (size_t)(row - TP) * D;
        const float* md = mod + seq_of_row(row) * 6144;
        f32x4 v[4]; float s = 0.f;
#pragma unroll
        for (int j = 0; j < 4; ++j) { v[j] = *(const f32x4*)(xr + 4 * lane + 256 * j); s += (v[j].x + v[j].y) + (v[j].z + v[j].w); }
        const float mean = wave_sum(s) * (1.f / D); float s2 = 0.f;
#pragma unroll
        for (int j = 0; j < 4; ++j) { v[j] = v[j] - mean; s2 += (v[j].x * v[j].x + v[j].y * v[j].y) + (v[j].z * v[j].z + v[j].w * v[j].w); }
        const float rstd = 1.f / sqrtf(wave_sum(s2) * (1.f / D) + LN_EPS);
        bf16* orow = (bf16*)(ws + WS_XN) + (size_t)row * D;
#pragma unroll
        for (int j = 0; j < 4; ++j) { const int col = 4 * lane + 256 * j; const f32x4 sh = *(const f32x4*)(md + col), sc = *(const f32x4*)(md + 1024 + col);
            v[j] = v[j] * rstd * (sc + 1.0f) + sh;
            v2u o; o.x = pk2(v[j].x, v[j].y); o.y = pk2(v[j].z, v[j].w); *(v2u*)(orow + col) = o; }
        float d[8];
#pragma unroll
        for (int c = 0; c < 8; ++c) { float acc = 0.f;
#pragma unroll
            for (int j = 0; j < 4; ++j) { const f32x4 w = *(const LAS f32x4*)(wx + c * 1024 + 4 * lane + 256 * j); acc += (v[j].x * w.x + v[j].y * w.y) + (v[j].z * w.z + v[j].w * w.w); }
            d[c] = wave_sum(acc); }
        float ov = d[0];
#pragma unroll
        for (int c = 1; c < 8; ++c) ov = lane == c ? d[c] : ov;
        if (lane < 8) ((float*)(ws + WS_BA))[(size_t)row * 8 + lane] = ov;
    }
}

constexpr int GP_KS = 0, GP_QS = 17408, GP_VS = 34816, GP_WB = 67584, GP_AS = 84992, GP_QK = 101376, GP_TB = 110592, GP_DEC = 114688;
DI void gdn_prep_item(const Args& a, LAS unsigned char* L, int item, int tid, int lane, int wave) {
    unsigned char* ws = a.ws;
    asm volatile("" : "+v"(L), "+v"(tid), "+v"(lane));
    const int c = item >> 2, h = item & 3;
    const int seq = c < 256 ? (c >> 6) : 4 + (c - 256), cis = c < 256 ? (c & 63) : 0, row0 = 64 * c;
    const bool last_chunk = c < 256 ? (cis == 63) : true;
    LAS bf16* Ks = (LAS bf16*)(L + GP_KS); LAS bf16* Qs = (LAS bf16*)(L + GP_QS); LAS bf16* Wb = (LAS bf16*)(L + GP_WB); LAS float* Tb = (LAS float*)(L + GP_TB);
    LAS float* Vs = (LAS float*)(L + GP_VS); LAS float* As = (LAS float*)(L + GP_AS); LAS bf16* QKs = (LAS bf16*)(L + GP_QK);
    LAS float* dec = (LAS float*)(L + GP_DEC); LAS float* betas = dec + 64; LAS float* edec = dec + 128; LAS float* edl = dec + 192;
    unsigned char* gbase = ws + WS_GDN + (size_t)item * GDN_ITEM;
#ifndef REP_S1
#define REP_S1 1
#endif
    for (int rep_ = 0; rep_ < REP_S1; ++rep_) {
        const int t0 = 8 * wave, ch = h * 128 + 2 * lane;
#pragma unroll
        for (int which = 0; which < 3; ++which) {
            const bf16* src = (const bf16*)(ws + WS_PQ + (size_t)which * PSZ);
            float x[11][2];
#pragma unroll
            for (int i = 0; i < 11; ++i) { const int t = t0 - 3 + i;
                if (t >= 0 || cis > 0) { const unsigned u = *(const unsigned*)(src + (size_t)(row0 + t) * 512 + ch); x[i][0] = bf2f((unsigned short)(u & 0xffffu)); x[i][1] = bf2f((unsigned short)(u >> 16)); }
                else if (seq >= 4) { const f32x2 cv = *(const f32x2*)(a.in[I_CONV] + (size_t)((seq - 4) * 3 + (3 + t)) * 1536 + which * 512 + ch); x[i][0] = cv.x; x[i][1] = cv.y; }
                else { x[i][0] = 0.f; x[i][1] = 0.f; } }
            float cw[4][2];
#pragma unroll
            for (int j = 0; j < 4; ++j) { const f32x2 w2 = *(const f32x2*)(a.in[I_CONVW] + (size_t)j * 1536 + which * 512 + ch); cw[j][0] = w2.x; cw[j][1] = w2.y; }
#pragma unroll
            for (int tt = 0; tt < 8; ++tt) {
                float y0 = 0.f, y1 = 0.f;
#pragma unroll
                for (int j = 0; j < 4; ++j) { y0 += cw[j][0] * x[tt + j][0]; y1 += cw[j][1] * x[tt + j][1]; }
                y0 = y0 / (1.0f + __expf(-y0)); y1 = y1 / (1.0f + __expf(-y1));
                if (which < 2) { const float ss = wave_sum(y0 * y0 + y1 * y1); const float sc = (which == 0 ? 0.08838834764831845f : 1.0f) / sqrtf(ss + RMS_EPS);
                    *(LAS unsigned*)((which == 0 ? Qs : Ks) + (t0 + tt) * 136 + 2 * lane) = pk2(y0 * sc, y1 * sc); }
                else *(LAS f32x2*)(Vs + (t0 + tt) * 128 + 2 * lane) = (f32x2){y0, y1};
            }
            if (last_chunk && wave == 7) {
                float* co = a.out + (seq < 4 ? O_CONV_P + (size_t)seq * 3 * 1536 : O_CONV_S + (size_t)(seq - 4) * 3 * 1536) + which * 512 + ch;
#pragma unroll
                for (int j = 0; j < 3; ++j) *(f32x2*)(co + (size_t)j * 1536) = (f32x2){x[8 + j][0], x[8 + j][1]};
            }
        }
    }
    if (wave == 0) {
        const float* BA = (const float*)(ws + WS_BA) + (size_t)(row0 + lane) * 8;
        const float braw = BA[h], araw = BA[4 + h];
        const float beta = 1.0f / (1.0f + expf(-braw));
        const float xx = araw + a.in[I_DTB][h]; const float sp = xx > 20.f ? xx : log1pf(expf(xx));
        float g = -expf(a.in[I_ALOG][h]) * sp;
#pragma unroll
        for (int o = 1; o < 64; o <<= 1) { const float t = __shfl_up(g, o); if (lane >= o) g += t; }
        const float dl = __shfl(g, 63);
        dec[lane] = g; betas[lane] = beta; edec[lane] = expf(g); edl[lane] = expf(dl - g);
        if (lane == 0) ((float*)(ws + WS_MISC + MISC_GL))[item] = expf(dl);
    }
    __syncthreads();
    {
        const int mat = wave >> 2, ti = wave & 3, r16 = lane & 15, kq = lane >> 4;
        const LAS bf16* Asrc = mat ? Qs : Ks;
        bf16x8 afr[4];
#pragma unroll
        for (int s = 0; s < 4; ++s) afr[s] = *(const LAS bf16x8*)(Asrc + (16 * ti + r16) * 136 + 32 * s + 8 * kq);
        for (int tj = 0; tj < 4; ++tj) {
            f32x4 acc = (f32x4){0.f, 0.f, 0.f, 0.f};
            if (tj <= ti) {
#pragma unroll
                for (int s = 0; s < 4; ++s) { const bf16x8 b = *(const LAS bf16x8*)(Ks + (16 * tj + r16) * 136 + 32 * s + 8 * kq); acc = MFMA16(afr[s], b, acc); }
            }
            const int j = 16 * tj + r16; const float dj = dec[j];
#pragma unroll
            for (int reg = 0; reg < 4; ++reg) { const int i = 16 * ti + 4 * kq + reg;
                if (mat == 0) { const float v = (j < i) ? betas[i] * acc[reg] * expf(dec[i] - dj) : 0.f; As[i * 64 + j] = v; }
                else { const float v = (j <= i) ? acc[reg] * expf(dec[i] - dj) : 0.f; QKs[i * 72 + j] = f2bf(v); } }
        }
    }
    __syncthreads();
    if (wave == 0) {
        const int b = lane >> 4, c = lane & 15;
        float t[16];
#pragma unroll
        for (int r = 0; r < 16; ++r) {
            float acc = (r == c) ? 1.0f : 0.0f;
#pragma unroll
            for (int j4 = 0; j4 < (r + 3) / 4; ++j4) { const f32x4 av = *(const LAS f32x4*)(As + (16 * b + r) * 64 + 16 * b + 4 * j4);
#pragma unroll
                for (int e = 0; e < 4; ++e) if (4 * j4 + e < r) acc -= av[e] * t[4 * j4 + e]; }
            t[r] = acc;
            Tb[(b * 16 + r) * 16 + c] = acc;
        }
    } else {
        for (int chunk0 = tid - 64; chunk0 < 2560; chunk0 += 448) {
            if (chunk0 < 1024) {
                const int chunk = chunk0, fl = chunk & 63, s = (chunk >> 6) & 7, mt = chunk >> 9, tok = 32 * mt + (fl & 31), hh = fl >> 5;
                const bf16x4 p0 = *(const LAS bf16x4*)(Qs + tok * 136 + 16 * s + 4 * hh), p1 = *(const LAS bf16x4*)(Qs + tok * 136 + 16 * s + 8 + 4 * hh); const float e = edec[tok];
                v4u o; o.x = pk2(bf2f(p0[0]) * e, bf2f(p0[1]) * e); o.y = pk2(bf2f(p0[2]) * e, bf2f(p0[3]) * e); o.z = pk2(bf2f(p1[0]) * e, bf2f(p1[1]) * e); o.w = pk2(bf2f(p1[2]) * e, bf2f(p1[3]) * e);
                ((v4u*)(gbase + G_QD))[chunk] = o;
            } else if (chunk0 < 1536) {
                const int chunk = chunk0 - 1024, fl = chunk & 63, k4 = (chunk >> 6) & 3, mt = chunk >> 8, i = 32 * mt + (fl & 31), hh = fl >> 5;
                const v2u p0 = *(const LAS v2u*)(QKs + i * 72 + 16 * k4 + 4 * hh), p1 = *(const LAS v2u*)(QKs + i * 72 + 16 * k4 + 8 + 4 * hh);
                ((v4u*)(gbase + G_QK))[chunk] = (v4u){p0.x, p0.y, p1.x, p1.y};
            } else {
                const int chunk = chunk0 - 1536, fl = chunk & 63, k4 = (chunk >> 6) & 3, mtk = chunk >> 8, dk = 32 * mtk + (fl & 31), hh = fl >> 5;
                float v[8];
#pragma unroll
                for (int j = 0; j < 8; ++j) { const int tok = 16 * k4 + 8 * (j >> 2) + 4 * hh + (j & 3); v[j] = bf2f(Ks[tok * 136 + dk]) * edl[tok]; }
                v4u o; o.x = pk2(v[0], v[1]); o.y = pk2(v[2], v[3]); o.z = pk2(v[4], v[5]); o.w = pk2(v[6], v[7]);
                ((v4u*)(gbase + G_KD))[chunk] = o;
            }
        }
    }
    __syncthreads();
#ifndef REP_S4
#define REP_S4 1
#endif
    for (int rep_ = 0; rep_ < REP_S4; ++rep_) {
        const int r16 = lane & 15, g = lane >> 4, ctb = 2 * (wave & 3);
        const bool is_u = wave < 4;
        f32x4 X[2][4];
#pragma unroll
        for (int b = 0; b < 4; ++b) {
            f32x4 acc[2];
#pragma unroll
            for (int t = 0; t < 2; ++t) { const int col = 16 * (ctb + t) + r16;
#pragma unroll
                for (int reg = 0; reg < 4; ++reg) { const int row = 16 * b + 4 * g + reg;
                    acc[t][reg] = is_u ? Vs[row * 128 + col] * betas[row] : bf2f(Ks[row * 136 + col]) * (betas[row] * edec[row]); } }
#pragma unroll
            for (int bp = 0; bp < b; ++bp) {
                const f32x4 av = *(const LAS f32x4*)(As + (16 * b + r16) * 64 + 16 * bp + 4 * g);
#pragma unroll
                for (int reg = 0; reg < 4; ++reg) { acc[0] = MFMA4(-av[reg], X[0][bp][reg], acc[0]); acc[1] = MFMA4(-av[reg], X[1][bp][reg], acc[1]); }
            }
            const f32x4 tv = *(const LAS f32x4*)(Tb + (b * 16 + r16) * 16 + 4 * g);
            f32x4 x0 = (f32x4){0.f, 0.f, 0.f, 0.f}, x1 = (f32x4){0.f, 0.f, 0.f, 0.f};
#pragma unroll
            for (int reg = 0; reg < 4; ++reg) { x0 = MFMA4(tv[reg], acc[0][reg], x0); x1 = MFMA4(tv[reg], acc[1][reg], x1); }
            X[0][b] = x0; X[1][b] = x1;
            if (is_u) {
                f32x4* U4 = (f32x4*)(gbase + G_U);
#pragma unroll
                for (int t = 0; t < 2; ++t) { const int ct = ctb + t, sl = ct >> 1, l32 = 16 * (ct & 1) + r16, mt = b >> 1, q = 2 * (b & 1) + (g >> 1), hf = g & 1;
                    U4[(((sl * 2 + mt) * 4 + q) * 2 + hf) * 32 + l32] = t ? x1 : x0; }
            } else {
#pragma unroll
                for (int t = 0; t < 2; ++t)
#pragma unroll
                    for (int reg = 0; reg < 4; ++reg) Wb[(16 * b + 4 * g + reg) * 136 + 16 * (ctb + t) + r16] = f2bf(-(t ? x1[reg] : x0[reg]));
            }
        }
    }
    __syncthreads();
#pragma unroll
    for (int q = 0; q < 2; ++q) { const int chunk = tid + 512 * q, fl = chunk & 63, s = (chunk >> 6) & 7, mt = chunk >> 9, tok = 32 * mt + (fl & 31), hh = fl >> 5;
        const v2u p0 = *(const LAS v2u*)(Wb + tok * 136 + 16 * s + 4 * hh), p1 = *(const LAS v2u*)(Wb + tok * 136 + 16 * s + 8 + 4 * hh);
        ((v4u*)(gbase + G_WN))[chunk] = (v4u){p0.x, p0.y, p1.x, p1.y}; }
}

template <bool FINAL>
DI void s5_item(const Args& a, LAS unsigned char* Hs8, int pi, int g, int lane) {
    unsigned char* ws = a.ws;
    const int n = lane & 31, hh = lane >> 5;
    const int cx = 2 * pi, cy = 2 * pi + 1, myc = hh ? cy : cx;
    const int half_r = (n >> 2) & 1, idx_r = (n & 3) + 4 * (n >> 3);
    const int arow0 = 64 * (half_r ? cy : cx) + idx_r;
    const bf16* PU = (const bf16*)(ws + WS_PU);
    const bf16x8* BF = (const bf16x8*)(ws + WS_MISC + MISC_BF) + (size_t)(g * 4) * 64 + lane;
    bf16x8 bfr[4];
#pragma unroll
    for (int tt = 0; tt < 4; ++tt) bfr[tt] = BF[tt * 64];
    const f32x4* AB = (const f32x4*)(ws + WS_MISC + MISC_S5AB) + g * 64;
    const f32x4 ab0 = AB[n], ab1 = AB[n + 32];
    float h0r = 0.f, h0i = 0.f, h1r = 0.f, h1i = 0.f;
    const f32x2* E = (const f32x2*)(ws + WS_E);
    bf16x8 cfr[4]; float dsk = 0.f;
    LAS bf16* Hs = (LAS bf16*)Hs8;
    if (FINAL) {
        const bf16x8* CF = (const bf16x8*)(ws + WS_MISC + MISC_CF) + (size_t)(g * 4) * 64 + lane;
#pragma unroll
        for (int s = 0; s < 4; ++s) cfr[s] = CF[s * 64];
        dsk = a.in[I_S5D][16 * g + (lane & 15)];
        if (cx >= 256) {
            const int b = myc - 256;
            h0r = a.in[I_S5RE][(size_t)(b * 32 + g) * 64 + n]; h0i = a.in[I_S5IM][(size_t)(b * 32 + g) * 64 + n];
            h1r = a.in[I_S5RE][(size_t)(b * 32 + g) * 64 + n + 32]; h1i = a.in[I_S5IM][(size_t)(b * 32 + g) * 64 + n + 32];
        } else {
            const int cf = cx & ~63;
#pragma unroll 4
            for (int cp = cf; cp < cy; ++cp) {
                const f32x2 e0 = E[(size_t)(cp * 32 + g) * 64 + n], e1 = E[(size_t)(cp * 32 + g) * 64 + n + 32];
                const float n0r = ab0.z * h0r - ab0.w * h0i + e0.x, n0i = ab0.z * h0i + ab0.w * h0r + e0.y;
                const float n1r = ab1.z * h1r - ab1.w * h1i + e1.x, n1i = ab1.z * h1i + ab1.w * h1r + e1.y;
                const bool act = cp < myc;
                h0r = act ? n0r : h0r; h0i = act ? n0i : h0i; h1r = act ? n1r : h1r; h1i = act ? n1i : h1i;
            }
        }
    }
    const f32x16 zero = {0.f, 0.f, 0.f, 0.f, 0.f, 0.f, 0.f, 0.f, 0.f, 0.f, 0.f, 0.f, 0.f, 0.f, 0.f, 0.f};
    for (int sb = 0; sb < 4; ++sb) {
        const bf16x8 ua = *(const bf16x8*)(PU + (size_t)(arow0 + 16 * sb) * 512 + 16 * g + 8 * hh);
        f32x16 X0 = MFMA32(ua, bfr[0], zero), X1 = MFMA32(ua, bfr[1], zero), X2 = MFMA32(ua, bfr[2], zero), X3 = MFMA32(ua, bfr[3], zero);
#pragma unroll
        for (int idx = 0; idx < 16; ++idx) {
            const float t0r = ab0.x * h0r - ab0.y * h0i + X0[idx], t0i = ab0.x * h0i + ab0.y * h0r + X2[idx];
            const float t1r = ab1.x * h1r - ab1.y * h1i + X1[idx], t1i = ab1.x * h1i + ab1.y * h1r + X3[idx];
            h0r = t0r; h0i = t0i; h1r = t1r; h1i = t1i;
            if (FINAL) { v2u o; o.x = pk2(h0r, h0i); o.y = pk2(h1r, h1i); *(LAS v2u*)(Hs + (16 * hh + idx) * 136 + 4 * n) = o; }
        }
        if (FINAL) {
            LDS_WAIT();
            const int r16 = lane & 15, kq = lane >> 4;
#pragma unroll
            for (int mi = 0; mi < 2; ++mi) {
                f32x4 y = (f32x4){0.f, 0.f, 0.f, 0.f};
#pragma unroll
                for (int s = 0; s < 4; ++s) { const bf16x8 av = *(const LAS bf16x8*)(Hs + (16 * mi + r16) * 136 + 32 * s + 8 * kq); y = MFMA16(av, cfr[s], y); }
                const int tokb = 64 * (mi ? cy : cx) + 16 * sb + 4 * kq;
#pragma unroll
                for (int reg = 0; reg < 4; ++reg) { const size_t off = (size_t)(tokb + reg) * 512 + 16 * g + r16;
                    const float yy = y[reg] + dsk * bf2f(PU[off]);
                    const float inner = 1.5957691216057308f * (yy + 0.044715f * yy * yy * yy);
                    ((bf16*)(ws + WS_YA))[off] = f2bf(yy / (1.0f + __expf(-inner))); }
            }
            LDS_WAIT();
        }
    }
    if (!FINAL) {
        f32x2* Ew = (f32x2*)(ws + WS_E);
        Ew[(size_t)(myc * 32 + g) * 64 + n] = (f32x2){h0r, h0i}; Ew[(size_t)(myc * 32 + g) * 64 + n + 32] = (f32x2){h1r, h1i};
    } else {
        const bool lastc = myc >= 256 || (myc & 63) == 63;
        if (lastc) {
            const size_t ore = myc >= 256 ? O_S5RE_S + (size_t)((myc - 256) * 32 + g) * 64 : O_S5RE_P + (size_t)((myc >> 6) * 32 + g) * 64;
            const size_t oim = myc >= 256 ? O_S5IM_S + (size_t)((myc - 256) * 32 + g) * 64 : O_S5IM_P + (size_t)((myc >> 6) * 32 + g) * 64;
            a.out[ore + n] = h0r; a.out[ore + n + 32] = h1r; a.out[oim + n] = h0i; a.out[oim + n + 32] = h1i;
        }
    }
}

constexpr int CH_SLOT = 57344;
DI void chain_stage(const unsigned char* ws, LAS unsigned char* L, int item, int slot, int lw, int lane) {
    asm volatile("" : "+v"(lane));
    const unsigned char* src = ws + WS_GDN + (size_t)item * GDN_ITEM + G_WN + lane * 16;
#pragma unroll
    for (int i = 0; i < 14; ++i) { const int chunk = lw * 14 + i;
        __builtin_amdgcn_global_load_lds((const unsigned*)(src + chunk * 1024), (LAS unsigned*)(L + slot * CH_SLOT + chunk * 1024), 16, 0, 0); }
}
#define CH_BARRIER() do { asm volatile("s_waitcnt lgkmcnt(0)" ::: "memory"); __builtin_amdgcn_s_barrier(); asm volatile("" ::: "memory"); } while (0)
DI void gdn_chain_wg(const Args& a, LAS unsigned char* L, int seq, int h, int wave, int lane) {
    unsigned char* ws = a.ws;
    const int nch = seq < 4 ? 64 : 1, c0 = seq < 4 ? seq * 64 : 256 + (seq - 4);
    if (wave >= 4) {
        chain_stage(ws, L, c0 * 4 + h, 0, wave - 4, lane); VM_WAIT();
        CH_BARRIER();
        for (int ci = 0; ci < nch; ++ci) {
            if (ci + 1 < nch) chain_stage(ws, L, (c0 + ci + 1) * 4 + h, (ci & 1) ^ 1, wave - 4, lane);
            VM_WAIT();
            CH_BARRIER();
        }
        return;
    }
    const int r = lane & 31, hh = lane >> 5, sl = wave;
    const float* GL = (const float*)(ws + WS_MISC + MISC_GL);
    const __amdgpu_buffer_rsrc_t rsO = __builtin_amdgcn_make_buffer_rsrc((void*)(ws + WS_OBUF), 0, (unsigned)((size_t)T * 512 * 4), 0x00020000);
    f32x16 S[4], vn[2]; float gln;
    if (seq >= 4) {
        const __amdgpu_buffer_rsrc_t rs0 = __builtin_amdgcn_make_buffer_rsrc((void*)(a.in[I_SGDN] + (size_t)((seq - 4) * 4 + h) * 16384), 0, 16384 * 4, 0x00020000);
#pragma unroll
        for (int mtk = 0; mtk < 4; ++mtk)
#pragma unroll
            for (int reg = 0; reg < 16; ++reg) S[mtk][reg] = __builtin_bit_cast(float, __builtin_amdgcn_raw_buffer_load_b32(rs0, (4 * hh * 128 + r) * 4, ((32 * mtk + (reg & 3) + 8 * (reg >> 2)) * 128 + 32 * sl) * 4, 0));
    } else {
#pragma unroll
        for (int mtk = 0; mtk < 4; ++mtk)
#pragma unroll
            for (int reg = 0; reg < 16; ++reg) S[mtk][reg] = 0.f;
    }
    {
        const f32x4* U4 = (const f32x4*)(ws + WS_GDN + (size_t)(c0 * 4 + h) * GDN_ITEM + G_U);
#pragma unroll
        for (int mt = 0; mt < 2; ++mt)
#pragma unroll
            for (int q = 0; q < 4; ++q) { const f32x4 u = U4[(((sl * 2 + mt) * 4 + q) * 2 + hh) * 32 + r]; vn[mt][4 * q] = u.x; vn[mt][4 * q + 1] = u.y; vn[mt][4 * q + 2] = u.z; vn[mt][4 * q + 3] = u.w; }
        gln = GL[c0 * 4 + h];
    }
    CH_BARRIER();
    for (int ci = 0; ci < nch; ++ci) {
        const int item = (c0 + ci) * 4 + h, slot = ci & 1;
        const LAS bf16x8* F = (const LAS bf16x8*)(L + slot * CH_SLOT) + lane;
        f32x16 o[2];
        const float gl = gln;
        if (ci + 1 < nch) gln = GL[item + 4];
#pragma unroll
        for (int reg = 0; reg < 16; ++reg) { o[0][reg] = 0.f; o[1][reg] = 0.f; }
#pragma unroll
        for (int s = 0; s < 8; ++s) {
            const bf16x8 Sb = pack8(S[s >> 1], s & 1);
            vn[0] = MFMA32(F[(0 * 8 + s) * 64], Sb, vn[0]); vn[1] = MFMA32(F[(1 * 8 + s) * 64], Sb, vn[1]);
            o[0] = MFMA32(F[1024 + (0 * 8 + s) * 64], Sb, o[0]); o[1] = MFMA32(F[1024 + (1 * 8 + s) * 64], Sb, o[1]);
        }
        bf16x8 vb[4];
#pragma unroll
        for (int k4 = 0; k4 < 4; ++k4) vb[k4] = pack8(vn[k4 >> 1], k4 & 1);
        if (ci + 1 < nch) {
            const f32x4* U4 = (const f32x4*)(ws + WS_GDN + (size_t)(item + 4) * GDN_ITEM + G_U);
#pragma unroll
            for (int mt = 0; mt < 2; ++mt)
#pragma unroll
                for (int q = 0; q < 4; ++q) { const f32x4 u = U4[(((sl * 2 + mt) * 4 + q) * 2 + hh) * 32 + r]; vn[mt][4 * q] = u.x; vn[mt][4 * q + 1] = u.y; vn[mt][4 * q + 2] = u.z; vn[mt][4 * q + 3] = u.w; }
        }
#pragma unroll
        for (int mt = 0; mt < 2; ++mt)
#pragma unroll
            for (int k4 = 0; k4 < 4; ++k4) o[mt] = MFMA32(F[2048 + (mt * 4 + k4) * 64], vb[k4], o[mt]);
#pragma unroll
        for (int mtk = 0; mtk < 4; ++mtk) {
            S[mtk] = S[mtk] * gl;
#pragma unroll
            for (int k4 = 0; k4 < 4; ++k4) S[mtk] = MFMA32(F[2560 + (mtk * 4 + k4) * 64], vb[k4], S[mtk]);
        }
#pragma unroll
        for (int mt = 0; mt < 2; ++mt)
#pragma unroll
            for (int reg = 0; reg < 16; ++reg) { const float ov = o[mt][reg];
                __builtin_amdgcn_raw_buffer_store_b32(__float_as_uint(ov), rsO, (4 * hh * 512 + r) * 4, (((c0 + ci) * 64 + 32 * mt + (reg & 3) + 8 * (reg >> 2)) * 512 + h * 128 + 32 * sl) * 4, 0); }
        CH_BARRIER();
    }
    const __amdgpu_buffer_rsrc_t rsS = __builtin_amdgcn_make_buffer_rsrc((void*)(a.out + (seq < 4 ? O_GDN_P + (size_t)(seq * 4 + h) * 16384 : O_GDN_S + (size_t)((seq - 4) * 4 + h) * 16384)), 0, 16384 * 4, 0x00020000);
#pragma unroll
    for (int mtk = 0; mtk < 4; ++mtk)
#pragma unroll
        for (int reg = 0; reg < 16; ++reg) { const float sv = S[mtk][reg];
            __builtin_amdgcn_raw_buffer_store_b32(__float_as_uint(sv), rsS, (4 * hh * 128 + r) * 4, ((32 * mtk + (reg & 3) + 8 * (reg >> 2)) * 128 + 32 * sl) * 4, 0); }
}

DI void gdn_norm_rows(const Args& a, int lane, int w0, int nw) {
    unsigned char* ws = a.ws;
    const int hd = lane >> 4, dv0 = (lane & 15) * 8, col = hd * 128 + dv0;
    const f32x4 g0 = *(const f32x4*)(a.in[I_NORMG] + dv0), g1 = *(const f32x4*)(a.in[I_NORMG] + dv0 + 4);
    for (int row = w0; row < T; row += nw) {
        const float* op = (const float*)(ws + WS_OBUF) + (size_t)row * 512 + col;
        const f32x4 o0 = *(const f32x4*)op, o1 = *(const f32x4*)(op + 4);
        float ss = (o0.x * o0.x + o0.y * o0.y) + (o0.z * o0.z + o0.w * o0.w) + (o1.x * o1.x + o1.y * o1.y) + (o1.z * o1.z + o1.w * o1.w);
        ss = row_sum(ss);
        const float rs = 1.0f / sqrtf(ss * (1.0f / 128.0f) + RMS_EPS);
        const bf16x8 z = *(const bf16x8*)((const bf16*)(ws + WS_PZ) + (size_t)row * 512 + col);
        float zz[8], y[8];
#pragma unroll
        for (int e = 0; e < 8; ++e) { const float zv = bf2f((unsigned short)z[e]); zz[e] = zv / (1.0f + __expf(-zv)); }
        y[0] = o0.x * rs * g0.x * zz[0]; y[1] = o0.y * rs * g0.y * zz[1]; y[2] = o0.z * rs * g0.z * zz[2]; y[3] = o0.w * rs * g0.w * zz[3];
        y[4] = o1.x * rs * g1.x * zz[4]; y[5] = o1.y * rs * g1.y * zz[5]; y[6] = o1.z * rs * g1.z * zz[6]; y[7] = o1.w * rs * g1.w * zz[7];
        v4u o; o.x = pk2(y[0], y[1]); o.y = pk2(y[2], y[3]); o.z = pk2(y[4], y[5]); o.w = pk2(y[6], y[7]);
        *(v4u*)((bf16*)(ws + WS_MIX) + (size_t)row * 1024 + 512 + col) = o;
    }
}

DI void phase7(const Args& a, int lane, int gw, int NGW) {
    unsigned char* ws = a.ws;
    const float* mod = (const float*)(ws + WS_MOD);
    f32x4 lg[4], lb[4];
#pragma unroll
    for (int j = 0; j < 4; ++j) { lg[j] = *(const f32x4*)(a.in[I_LN1G] + 4 * lane + 256 * j); lb[j] = *(const f32x4*)(a.in[I_LN1B] + 4 * lane + 256 * j); }
    for (int row = gw; row < T; row += NGW) {
        const float* xr = a.out + O_Y + (size_t)row * D;
        const float* md = mod + seq_of_row(row) * 6144;
        f32x4 v[4]; float s = 0.f;
#pragma unroll
        for (int j = 0; j < 4; ++j) { v[j] = *(const f32x4*)(xr + 4 * lane + 256 * j); s += (v[j].x + v[j].y) + (v[j].z + v[j].w); }
        float mean = wave_sum(s) * (1.f / D), s2 = 0.f;
#pragma unroll
        for (int j = 0; j < 4; ++j) { v[j] = v[j] - mean; s2 += (v[j].x * v[j].x + v[j].y * v[j].y) + (v[j].z * v[j].z + v[j].w * v[j].w); }
        float rstd = 1.f / sqrtf(wave_sum(s2) * (1.f / D) + LN_EPS);
        float* x1 = (float*)(ws + WS_X1) + (size_t)row * D; s = 0.f;
#pragma unroll
        for (int j = 0; j < 4; ++j) { v[j] = v[j] * rstd * lg[j] + lb[j]; *(f32x4*)(x1 + 4 * lane + 256 * j) = v[j]; s += (v[j].x + v[j].y) + (v[j].z + v[j].w); }
        mean = wave_sum(s) * (1.f / D); s2 = 0.f;
#pragma unroll
        for (int j = 0; j < 4; ++j) { v[j] = v[j] - mean; s2 += (v[j].x * v[j].x + v[j].y * v[j].y) + (v[j].z * v[j].z + v[j].w * v[j].w); }
        rstd = 1.f / sqrtf(wave_sum(s2) * (1.f / D) + LN_EPS);
        bf16* orow = (bf16*)(ws + WS_XN) + (size_t)row * D;
#pragma unroll
        for (int j = 0; j < 4; ++j) { const int col = 4 * lane + 256 * j; const f32x4 sh = *(const f32x4*)(md + 3072 + col), sc = *(const f32x4*)(md + 4096 + col);
            const f32x4 hv = v[j] * rstd * (sc + 1.0f) + sh;
            v2u o; o.x = pk2(hv.x, hv.y); o.y = pk2(hv.z, hv.w); *(v2u*)(orow + col) = o; }
    }
}
DI void phase10(const Args& a, int lane, int gw, int NGW) {
    f32x4 lg[4], lb[4];
#pragma unroll
    for (int j = 0; j < 4; ++j) { lg[j] = *(const f32x4*)(a.in[I_LN2G] + 4 * lane + 256 * j); lb[j] = *(const f32x4*)(a.in[I_LN2B] + 4 * lane + 256 * j); }
    for (int row = gw; row < T; row += NGW) {
        float* xr = a.out + O_Y + (size_t)row * D;
        f32x4 v[4]; float s = 0.f;
#pragma unroll
        for (int j = 0; j < 4; ++j) { v[j] = *(const f32x4*)(xr + 4 * lane + 256 * j); s += (v[j].x + v[j].y) + (v[j].z + v[j].w); }
        const float mean = wave_sum(s) * (1.f / D); float s2 = 0.f;
#pragma unroll
        for (int j = 0; j < 4; ++j) { v[j] = v[j] - mean; s2 += (v[j].x * v[j].x + v[j].y * v[j].y) + (v[j].z * v[j].z + v[j].w * v[j].w); }
        const float rstd = 1.f / sqrtf(wave_sum(s2) * (1.f / D) + LN_EPS);
#pragma unroll
        for (int j = 0; j < 4; ++j) *(f32x4*)(xr + 4 * lane + 256 * j) = v[j] * rstd * lg[j] + lb[j];
    }
}
#define XB_TMO      128
#define XB_XCNT(j)  (256  + 64 * (j))
#define XB_XSUB(j)  (1280 + 64 * (j))
#define XB_XGEN(j)  (2304 + 64 * (j))
#define XB_TOP      3328
#define XB_TOPGEN   3392
#define XCD_BAR_WORDS 3456
#define XB_SPIN_CAP (1u << 18)

__device__ __forceinline__ unsigned xb_ld(unsigned* p)              { return __hip_atomic_load(p, __ATOMIC_RELAXED, __HIP_MEMORY_SCOPE_AGENT); }
__device__ __forceinline__ unsigned xb_add(unsigned* p, unsigned v) { return __hip_atomic_fetch_add(p, v, __ATOMIC_RELAXED, __HIP_MEMORY_SCOPE_AGENT); }
__device__ __forceinline__ unsigned xb_xcc_id() { return (unsigned)__builtin_amdgcn_s_getreg((3 << 11) | 20) & 0xFu; }
#define XB_SPIN(cond, bar) do { unsigned _sp = 0; while (cond) { __builtin_amdgcn_s_sleep(1); \
    if ((++_sp & 255u) == 0u) { if (xb_ld(&(bar)[XB_TMO])) break; if (_sp > XB_SPIN_CAP) { atomicAdd(&(bar)[XB_TMO], 1u); break; } } } } while (0)

struct XcdBarrier {
    unsigned* bar; unsigned x;
    volatile LAS unsigned* st;
};

__device__ __forceinline__ XcdBarrier xcd_barrier_post(unsigned* bar, volatile LAS unsigned* st) {
    XcdBarrier b; b.bar = bar; b.x = xb_xcc_id(); b.st = st;
    if (threadIdx.x == 0) (void)xb_add(&bar[XB_XCNT(b.x)], 1u);
    return b;
}
__device__ __forceinline__ void xcd_barrier_complete(unsigned* bar, unsigned x, unsigned& nloc, unsigned& nx) {
    const unsigned G = gridDim.x * gridDim.y * gridDim.z;
    unsigned sum, cnt, mine, sp = 0u;
    for (;;) {
        sum = 0u; cnt = 0u; mine = 0u;
#pragma unroll
        for (unsigned j = 0; j < 16; ++j) { const unsigned c = xb_ld(&bar[XB_XCNT(j)]); sum += c; cnt += (c > 0u) ? 1u : 0u; mine = (j == x) ? c : mine; }
        if (sum == G) break;
        __builtin_amdgcn_s_sleep(1);
        if ((++sp & 255u) == 0u) { if (xb_ld(&bar[XB_TMO])) break; if (sp > XB_SPIN_CAP) { atomicAdd(&bar[XB_TMO], 1u); break; } }
    }
    nloc = mine > 0u ? mine : 1u; nx = cnt > 0u ? cnt : 1u;
}

__device__ __forceinline__ void xcd_barrier(const XcdBarrier& b) {
    asm volatile("s_waitcnt vmcnt(0)" ::: "memory");
    __syncthreads();
    if (threadIdx.x == 0) {
        unsigned* bar = b.bar;
        __builtin_amdgcn_s_waitcnt(0);
        unsigned nloc = b.st[0], nx = b.st[1];
        if (nloc == 0u) { xcd_barrier_complete(bar, b.x, nloc, nx); b.st[0] = nloc; b.st[1] = nx; }
        const unsigned old = xb_add(&bar[XB_XSUB(b.x)], 1u);
        const unsigned gen = old / nloc;
        if (old + 1u == (gen + 1u) * nloc) {
            __builtin_amdgcn_fence(__ATOMIC_RELEASE, "agent");
            asm volatile("s_waitcnt vmcnt(0)" ::: "memory");
            const unsigned og = xb_add(&bar[XB_TOP], 1u);
            const unsigned tg = og / nx;
            if (og + 1u == (tg + 1u) * nx) xb_add(&bar[XB_TOPGEN], 1u);
            else XB_SPIN(xb_ld(&bar[XB_TOPGEN]) == tg, bar);
            __builtin_amdgcn_fence(__ATOMIC_ACQUIRE, "agent");
            xb_add(&bar[XB_XGEN(b.x)], 1u);
            asm volatile("s_waitcnt vmcnt(0)" ::: "memory");
        } else {
            XB_SPIN(xb_ld(&bar[XB_XGEN(b.x)]) == gen, bar);
            __builtin_amdgcn_fence(__ATOMIC_ACQUIRE, "agent");
            asm volatile("s_waitcnt vmcnt(0)" ::: "memory");
        }
    }
    __syncthreads();
}

#ifndef MK_N_LAUNCHES
#define MK_N_LAUNCHES 1
#endif
constexpr int N_PHASES = 11;
constexpr int N_CHAIN = 48;

__global__ void __launch_bounds__(NWAVES * 64, 2) fwd_kernel(Args args) {
    extern __shared__ __attribute__((aligned(16))) unsigned char lds[];
    LAS unsigned char* L = (LAS unsigned char*)lds;
    const int tid = threadIdx.x, lane = tid & 63, wave = __builtin_amdgcn_readfirstlane(tid >> 6);
    const int G = gridDim.x, bx = blockIdx.x;
    const int vcu = (G % 8 == 0) ? (bx % 8) * (G / 8) + bx / 8 : bx;
    const int gw = vcu * NWAVES + wave, NGW = G * NWAVES;
    unsigned char* ws = args.ws;
    for (int u = tid; u < (LDS_BYTES - LDSCTL_OFF) / 4; u += NWAVES * 64) ((LAS unsigned*)(L + LDSCTL_OFF))[u] = 0u;
    __syncthreads();
    XcdBarrier bar = xcd_barrier_post((unsigned*)(ws + WS_CTL) + CW_BAR, (volatile LAS unsigned*)(L + MISC_OFF) + 8);
    const int lo = args.ph_lo, hi = args.ph_hi;
#ifndef PHASE_MASK
#define PHASE_MASK 0x7ff
#endif
#define IN(k) (((PHASE_MASK >> (k)) & 1) && lo <= (k) && (k) < hi)
#define SEAM(k) do { if (IN(k) && IN((k) + 1)) xcd_barrier(bar); } while (0)

#ifndef DUP_MASK
#define DUP_MASK 0
#endif
#ifndef REP_S5A
#define REP_S5A 1
#endif
#define RUNPH(kk, BODY) do { if (IN(kk)) { BODY; if (DUP_MASK & (1 << (kk))) { xcd_barrier(bar); BODY; } SEAM(kk); } } while (0)
#define PB0 phase0(args, L, tid, lane, wave, gw, NGW, dup_)
#define PB1 phase1(args, L, tid, lane, gw, NGW)
#define PB2 do { pg8::Gemm g{(const bf16*)(ws + WS_XN), (const bf16*)(ws + WS_WIN), T, NIN, D}; pg8::StaticOrder S; S.init(T, NIN, G, bx); \
        pg8::EpiBf16Split E{(bf16*)(ws + WS_PU), 512, 512, (size_t)T * 512}; \
        pg8::gemm_phase<pg8::EpiBf16Split, pg8::StaticOrder, true, true>(L, g, S, E); } while (0)
#define PB3 do { \
        for (int item = bx; item < NITEM; item += G) gdn_prep_item(args, L, item, tid, lane, wave); \
        for (int rep_ = 0; rep_ < REP_S5A; ++rep_) for (int it = gw; it < (NCHUNK / 2) * 32; it += NGW) s5_item<false>(args, L, it >> 5, it & 31, lane); } while (0)
#define PB4 do { \
        const int nchw = N_CHAIN;     \
        if (bx < nchw) { \
            { const int k = bx; const int seq = k < 16 ? (k >> 2) : 4 + ((k - 16) >> 2), h = k & 3; gdn_chain_wg(args, L, seq, h, wave, lane); } \
        } else { \
            const int wid = (bx - nchw) * NWAVES + wave, NW = (G - nchw) * NWAVES; \
            for (int it = wid; it < (NCHUNK / 2) * 32; it += NW) s5_item<true>(args, L + wave * 8704, it >> 5, it & 31, lane); \
        } } while (0)
#define PB5 do { pg8::Gemm g{(const bf16*)(ws + WS_YA), (const bf16*)(ws + WS_WGLU), T, 1024, 512}; pg8::StaticOrder S; S.init(T, 1024, G, bx); \
        pg8::EpiGate<0> E{(bf16*)(ws + WS_MIX), 1024}; \
        pg8::gemm_phase<pg8::EpiGate<0>, pg8::StaticOrder, true, true>(L, g, S, E); \
        gdn_norm_rows(args, lane, gw, NGW); } while (0)
#define PB6 do { pg8::Gemm g{(const bf16*)(ws + WS_MIX), (const bf16*)(ws + WS_WOUT), T, D, D}; pg8::StaticOrder S; S.init(T, D, G, bx); \
        pg8::EpiRes E{args.in[I_XP], args.in[I_XS], (const float*)(ws + WS_MOD) + 2048, args.out + O_Y, ALPHA}; \
        pg8::gemm_phase<pg8::EpiRes, pg8::StaticOrder, true, true>(L, g, S, E); } while (0)
#define PB7 phase7(args, lane, gw, NGW)
#define PB8 do { pg8::Gemm g{(const bf16*)(ws + WS_XN), (const bf16*)(ws + WS_WUP), T, 2 * DFF, D}; pg8::StaticOrder S; S.init(T, 2 * DFF, G, bx); \
        pg8::EpiGate<1> E{(bf16*)(ws + WS_HID), DFF}; \
        pg8::gemm_phase<pg8::EpiGate<1>, pg8::StaticOrder, true, true>(L, g, S, E); } while (0)
#define PB9 do { pg8::Gemm g{(const bf16*)(ws + WS_HID), (const bf16*)(ws + WS_WDOWN), T, D, DFF}; pg8::StaticOrder S; S.init(T, D, G, bx); \
        pg8::EpiRes E{(const float*)(ws + WS_X1), (const float*)(ws + WS_X1) + (size_t)TP * D, (const float*)(ws + WS_MOD) + 5120, args.out + O_Y, ALPHA}; \
        pg8::gemm_phase<pg8::EpiRes, pg8::StaticOrder, true, true>(L, g, S, E); } while (0)
    { int dup_ = 0; if (IN(0)) { PB0; if (DUP_MASK & 1) { xcd_barrier(bar); dup_ = 1; PB0; } SEAM(0); } }
    RUNPH(1, PB1); RUNPH(2, PB2); RUNPH(3, PB3); RUNPH(4, PB4); RUNPH(5, PB5); RUNPH(6, PB6); RUNPH(7, PB7); RUNPH(8, PB8); RUNPH(9, PB9);
    if (IN(10)) { phase10(args, lane, gw, NGW); }
#undef IN
#undef SEAM
}

extern "C" void kernel_launch(void* const* d_in, const int* in_sizes, int n_in, void* d_out, int out_size, void* d_ws, size_t ws_size, hipStream_t stream) {
    static int grid = 0;
    if (grid == 0) {
        if (n_in != N_IN || out_size != (int)O_END || ws_size < WS_END) { fprintf(stderr, "kernel_launch: unexpected shapes (n_in %d, out %d, ws %zu); nothing launched\n", n_in, out_size, ws_size); grid = -1; return; }
        int dev = 0, cus = 0, per_cu = 0;
        if (hipGetDevice(&dev) != hipSuccess || hipDeviceGetAttribute(&cus, hipDeviceAttributeMultiprocessorCount, dev) != hipSuccess) { grid = -1; return; }
        if (hipFuncSetAttribute((const void*)fwd_kernel, hipFuncAttributeMaxDynamicSharedMemorySize, LDS_BYTES) != hipSuccess) { fprintf(stderr, "kernel_launch: hipFuncSetAttribute failed\n"); grid = -1; return; }
        if (hipOccupancyMaxActiveBlocksPerMultiprocessor(&per_cu, (const void*)fwd_kernel, NWAVES * 64, LDS_BYTES) != hipSuccess || per_cu < 1) { fprintf(stderr, "kernel_launch: occupancy query says %d blocks per CU\n", per_cu); per_cu = 1; }
        (void)hipGetLastError();
        grid = cus;
        if (grid <= N_CHAIN) { fprintf(stderr, "kernel_launch: needs more than %d CUs\n", N_CHAIN); grid = -1; return; }
    }
    if (grid < 0) return;
    (void)hipMemsetAsync((char*)d_ws + WS_CTL, 0, CTL_ZERO_BYTES, stream);
    Args a{};
    for (int i = 0; i < N_IN; ++i) a.in[i] = (const float*)d_in[i];
    a.out = (float*)d_out; a.ws = (unsigned char*)d_ws;
#if MK_N_LAUNCHES == 1
    a.ph_lo = 0; a.ph_hi = N_PHASES;
    hipLaunchKernelGGL(fwd_kernel, dim3(grid), dim3(NWAVES * 64), LDS_BYTES, stream, a);
#else
    for (int p = 0; p < N_PHASES; ++p) { a.ph_lo = p; a.ph_hi = p + 1; hipLaunchKernelGGL(fwd_kernel, dim3(grid), dim3(NWAVES * 64), LDS_BYTES, stream, a); }
#endif
}
```
